# Optimizing an MI355X kernel written in HIP

```python
import jax, jax.numpy as jnp
from jax import lax
import numpy as np

D_MODEL = 1024
BATCH = 2
SEQ = 8192
DEPTH = 1

N_MEM = 256
ROPE_THETA = 10000.0
EPS = 1e-6
MAX_POS_OFFSET = 4096
NEG = -1e30
FORCE = 1e9

GLA_HEADS = 4
GLA_DK = D_MODEL // 2 // GLA_HEADS
GLA_DV = D_MODEL // GLA_HEADS
GLA_RANK = 16
GLA_TAU = 16.0
GLA_CHUNK = 64

NSA_HEADS = 16
NSA_KV_HEADS = 4
NSA_GROUP = NSA_HEADS // NSA_KV_HEADS
NSA_HD = D_MODEL // NSA_HEADS
CMP_LEN = 32
CMP_STRIDE = 16
CMP_HIDDEN = 256
SLC_BLOCK = 64
SLC_TOPN = 16
WINDOW = 512
NSA_Q_BLOCK = 64
N_NSA_BRANCH = 3

MEM_HEADS = 4
MEM_HD = D_MODEL // MEM_HEADS

N_BRANCH = 3
BRANCH_WIDTH = D_MODEL

SPLITS = (
    GLA_HEADS * GLA_DK,
    GLA_HEADS * GLA_DK,
    GLA_HEADS * GLA_DV,
    GLA_RANK,
    GLA_HEADS * GLA_DV,
    NSA_HEADS * NSA_HD,
    6 * NSA_KV_HEADS * NSA_HD,
    NSA_HEADS * N_NSA_BRANCH,
    NSA_HEADS * NSA_HD,
    MEM_HEADS * MEM_HD,
    MEM_HEADS * MEM_HD,
    N_BRANCH * D_MODEL,
)
D_IN = sum(SPLITS)

kernel_name = "hybrid_gla_nsa_memory_gated_block"


def rms_norm(x, gain):
    xf = x.astype(jnp.float32)
    y = xf * lax.rsqrt(jnp.mean(xf * xf, axis=-1, keepdims=True) + EPS)
    return (y * gain.astype(jnp.float32)).astype(x.dtype)


def rope(x, positions):
    half = x.shape[-1] // 2
    inv = ROPE_THETA ** (-jnp.arange(half, dtype=jnp.float32) / half)
    ang = positions.astype(jnp.float32)[..., None] * inv
    cos = jnp.cos(ang)[:, :, None, :]
    sin = jnp.sin(ang)[:, :, None, :]
    xf = x.astype(jnp.float32)
    x1, x2 = xf[..., :half], xf[..., half:]
    return jnp.concatenate([x1 * cos - x2 * sin, x2 * cos + x1 * sin], axis=-1).astype(x.dtype)


def gla_chunked(q, k, v, log_a):
    B, S, H, DK = q.shape
    DV = v.shape[-1]
    C = GLA_CHUNK
    nC = S // C
    f32 = jnp.float32

    def to_chunks(t):
        return t.astype(f32).reshape(B, nC, C, H, t.shape[-1]).transpose(1, 0, 3, 2, 4)

    qc, kc, vc = to_chunks(q), to_chunks(k), to_chunks(v)
    gc = jnp.cumsum(to_chunks(log_a), axis=3)
    causal = jnp.tril(jnp.ones((C, C), dtype=bool))

    def step(state, inp):
        qi, ki, vi, gi = inp
        diff = gi[:, :, :, None, :] - gi[:, :, None, :, :]
        decay = jnp.where(causal[:, :, None], jnp.exp(jnp.minimum(diff, 0.0)), 0.0)
        attn = jnp.einsum('bhijk,bhjk->bhij', qi[:, :, :, None, :] * decay, ki)
        o = attn @ vi + jnp.einsum('bhik,bhkv->bhiv', qi * jnp.exp(gi), state)
        g_last = gi[:, :, -1:, :]
        state = jnp.exp(g_last[:, :, 0, :])[..., None] * state + jnp.einsum(
            'bhjk,bhjv->bhkv', ki * jnp.exp(g_last - gi), vi)
        return state, o

    state0 = jnp.zeros((B, H, DK, DV), f32)
    _, o = lax.scan(step, state0, (qc, kc, vc, gc))
    return o.transpose(1, 0, 3, 2, 4).reshape(B, S, H, DV).astype(q.dtype)


def nsa_compress(tok, pe, w1, w2):
    S = tok.shape[1]
    n_cmp = (S - CMP_LEN) // CMP_STRIDE + 1
    idx = jnp.arange(n_cmp)[:, None] * CMP_STRIDE + jnp.arange(CMP_LEN)[None, :]
    blocks = tok[:, idx] + pe[None, None, :, None, :]
    h = jax.nn.gelu(jnp.einsum('bnlhd,ldf->bnhf', blocks, w1))
    return jnp.einsum('bnhf,fd->bnhd', h, w2)


def nsa_attention(q, kc, vc, k_slc, v_slc, k_win, v_win, gates):
    B, S, H, HD = q.shape
    Hkv, G, QB = NSA_KV_HEADS, NSA_GROUP, NSA_Q_BLOCK
    nQB = S // QB
    n_cmp = kc.shape[1]
    n_slc = S // SLC_BLOCK
    topn = min(SLC_TOPN, n_slc)
    scale = HD ** -0.5
    f32 = jnp.float32

    cmp_end = jnp.arange(n_cmp) * CMP_STRIDE + CMP_LEN - 1
    cs = np.arange(n_cmp)[:, None] * CMP_STRIDE
    ss = np.arange(n_slc)[None, :] * SLC_BLOCK
    ov = np.clip(np.minimum(cs + CMP_LEN, ss + SLC_BLOCK) - np.maximum(cs, ss), 0, None) / CMP_LEN
    ov = jnp.asarray(ov, f32)

    kc32, vc32 = kc.astype(f32), vc.astype(f32)
    k_sb = k_slc.reshape(B, n_slc, SLC_BLOCK, Hkv, HD).transpose(0, 3, 1, 2, 4)
    v_sb = v_slc.reshape(B, n_slc, SLC_BLOCK, Hkv, HD).transpose(0, 3, 1, 2, 4)
    kw = jnp.pad(k_win, ((0, 0), (WINDOW, 0), (0, 0), (0, 0)))
    vw = jnp.pad(v_win, ((0, 0), (WINDOW, 0), (0, 0), (0, 0)))
    qb = q.reshape(B, nQB, QB, Hkv, G, HD).transpose(1, 0, 3, 4, 2, 5)
    gb = gates.reshape(B, nQB, QB, H, N_NSA_BRANCH).transpose(1, 0, 2, 3, 4)
    bi = jnp.arange(B)[:, None, None, None]
    hi = jnp.arange(Hkv)[None, :, None, None]
    blk_id = jnp.arange(n_slc)

    def block_fn(args):
        blk, qi, gi = args
        t = blk * QB + jnp.arange(QB)
        qf = qi.astype(f32) * scale
        s = jnp.einsum('bhgqd,bnhd->bhgqn', qf, kc32)
        valid = cmp_end[None, :] <= t[:, None]
        p_cmp = jax.nn.softmax(jnp.where(valid, s, NEG), axis=-1) * valid
        o_cmp = jnp.einsum('bhgqn,bnhd->bhgqd', p_cmp, vc32)
        imp = jnp.einsum('bhgqn,ns->bhqs', p_cmp, ov)
        cur = t // SLC_BLOCK
        forced = (blk_id[None, :] == 0) | (blk_id[None, :] == cur[:, None]) | (blk_id[None, :] == cur[:, None] - 1)
        causal_blk = blk_id[None, :] <= cur[:, None]
        imp = jnp.where(forced, FORCE, jnp.where(causal_blk, imp, NEG))
        _, idx = lax.top_k(imp, topn)
        ks = k_sb[bi, hi, idx].astype(f32)
        vs = v_sb[bi, hi, idx].astype(f32)
        s = jnp.einsum('bhgqd,bhqnld->bhgqnl', qf, ks)
        kpos = idx[..., None] * SLC_BLOCK + jnp.arange(SLC_BLOCK)
        valid = kpos <= t[None, None, :, None, None]
        s = jnp.where(valid[:, :, None], s, NEG)
        p = jax.nn.softmax(s.reshape(s.shape[:4] + (-1,)), axis=-1).reshape(s.shape)
        o_slc = jnp.einsum('bhgqnl,bhqnld->bhgqd', p, vs)
        kwi = lax.dynamic_slice_in_dim(kw, blk * QB, WINDOW + QB, axis=1).astype(f32)
        vwi = lax.dynamic_slice_in_dim(vw, blk * QB, WINDOW + QB, axis=1).astype(f32)
        kp = blk * QB - WINDOW + jnp.arange(WINDOW + QB)
        valid = (kp[None, :] <= t[:, None]) & (kp[None, :] > t[:, None] - WINDOW) & (kp[None, :] >= 0)
        s = jnp.einsum('bhgqd,bkhd->bhgqk', qf, kwi)
        p = jax.nn.softmax(jnp.where(valid, s, NEG), axis=-1)
        o_win = jnp.einsum('bhgqk,bkhd->bhgqd', p, vwi)
        g = gi.astype(f32).reshape(B, QB, Hkv, G, N_NSA_BRANCH).transpose(0, 2, 3, 1, 4)
        o = g[..., 0:1] * o_cmp + g[..., 1:2] * o_slc + g[..., 2:3] * o_win
        return o.transpose(0, 3, 1, 2, 4).reshape(B, QB, H, HD).astype(q.dtype)

    out = lax.map(block_fn, (jnp.arange(nQB), qb, gb))
    return out.transpose(1, 0, 2, 3, 4).reshape(B, S, H * HD)


def memory_attention(q, k, v):
    s = jnp.einsum('bshd,bmhd->bhsm', q.astype(jnp.float32), k.astype(jnp.float32)) * (q.shape[-1] ** -0.5)
    p = jax.nn.softmax(s, axis=-1)
    return jnp.einsum('bhsm,bmhd->bshd', p, v.astype(jnp.float32)).astype(q.dtype)


def hybrid_layer(x, mem, positions, norm_gain, mem_norm_gain, w_in, w_gla_alpha, b_gla_alpha,
                 gla_out_norm, nsa_q_norm, nsa_k_norm, pe_cmp_k, pe_cmp_v, w_cmp_k1, w_cmp_k2,
                 w_cmp_v1, w_cmp_v2, w_mem_kv, mem_q_norm, mem_k_norm, w_branch, w_out):
    B, S, _ = x.shape
    xn = rms_norm(x, norm_gain)
    proj = xn @ w_in
    (gla_q, gla_k, gla_v, gla_lr, gla_gate, nsa_q, nsa_kv, nsa_g, nsa_gate,
     mem_q, mem_gate, merge) = jnp.split(proj, [int(c) for c in np.cumsum(SPLITS)[:-1]], axis=-1)

    q = gla_q.reshape(B, S, GLA_HEADS, GLA_DK) * (GLA_DK ** -0.5)
    k = gla_k.reshape(B, S, GLA_HEADS, GLA_DK)
    v = gla_v.reshape(B, S, GLA_HEADS, GLA_DV)
    log_a = jax.nn.log_sigmoid((gla_lr @ w_gla_alpha + b_gla_alpha).astype(jnp.float32)) / GLA_TAU
    o = gla_chunked(q, k, v, log_a.reshape(B, S, GLA_HEADS, GLA_DK))
    y_a = rms_norm(o, gla_out_norm).reshape(B, S, -1) * jax.nn.silu(gla_gate)

    q = rope(rms_norm(nsa_q.reshape(B, S, NSA_HEADS, NSA_HD), nsa_q_norm), positions)
    kv = nsa_kv.reshape(B, S, 6, NSA_KV_HEADS, NSA_HD)
    k_c = rope(rms_norm(kv[:, :, 0], nsa_k_norm[0]), positions)
    k_s = rope(rms_norm(kv[:, :, 2], nsa_k_norm[1]), positions)
    k_w = rope(rms_norm(kv[:, :, 4], nsa_k_norm[2]), positions)
    kc = nsa_compress(k_c, pe_cmp_k, w_cmp_k1, w_cmp_k2)
    vc = nsa_compress(kv[:, :, 1], pe_cmp_v, w_cmp_v1, w_cmp_v2)
    gates = jax.nn.sigmoid(nsa_g.reshape(B, S, NSA_HEADS, N_NSA_BRANCH))
    o = nsa_attention(q, kc, vc, k_s, kv[:, :, 3], k_w, kv[:, :, 5], gates)
    y_b = o * jax.nn.silu(nsa_gate)

    memn = rms_norm(mem, mem_norm_gain)
    mkv = (memn @ w_mem_kv).reshape(B, mem.shape[1], 2, MEM_HEADS, MEM_HD)
    mk = rms_norm(mkv[:, :, 0], mem_k_norm)
    mq = rms_norm(mem_q.reshape(B, S, MEM_HEADS, MEM_HD), mem_q_norm)
    o = memory_attention(mq, mk, mkv[:, :, 1])
    y_m = o.reshape(B, S, -1) * jax.nn.silu(mem_gate)

    branches = jnp.stack([y_a, y_b, y_m], axis=2)
    z = jnp.einsum('bscw,cwd->bscd', branches, w_branch)
    g = jax.nn.sigmoid(merge.reshape(B, S, N_BRANCH, D_MODEL))
    mixed = jnp.sum(g * z, axis=2)
    return x + mixed @ w_out


def setup_inputs(seed: int = 0) -> dict:
    key = jax.random.key(seed)
    ks = jax.random.split(key, 24)
    f32 = jnp.float32

    def normal(k, shape, scale):
        return jax.random.normal(k, shape, f32) * scale

    x = normal(ks[0], (BATCH, SEQ, D_MODEL), 1.0)
    mem = normal(ks[1], (BATCH, N_MEM, D_MODEL), 1.0)
    offset = jax.random.randint(ks[2], (BATCH,), 0, MAX_POS_OFFSET, dtype=jnp.int32)
    positions = (offset[:, None] + jnp.arange(SEQ, dtype=jnp.int32)[None, :]).astype(jnp.int32)
    return {
        "x": x,
        "mem": mem,
        "positions": positions,
        "norm_gain": 1.0 + normal(ks[3], (DEPTH, D_MODEL), 0.02),
        "mem_norm_gain": 1.0 + normal(ks[4], (DEPTH, D_MODEL), 0.02),
        "w_in": normal(ks[5], (DEPTH, D_MODEL, D_IN), D_MODEL ** -0.5),
        "w_gla_alpha": normal(ks[6], (DEPTH, GLA_RANK, GLA_HEADS * GLA_DK), GLA_RANK ** -0.5),
        "b_gla_alpha": normal(ks[7], (DEPTH, GLA_HEADS * GLA_DK), 0.1),
        "gla_out_norm": 1.0 + normal(ks[8], (DEPTH, GLA_DV), 0.02),
        "nsa_q_norm": 1.0 + normal(ks[9], (DEPTH, NSA_HD), 0.02),
        "nsa_k_norm": 1.0 + normal(ks[10], (DEPTH, N_NSA_BRANCH, NSA_HD), 0.02),
        "pe_cmp_k": normal(ks[11], (DEPTH, CMP_LEN, NSA_HD), 0.1),
        "pe_cmp_v": normal(ks[12], (DEPTH, CMP_LEN, NSA_HD), 0.1),
        "w_cmp_k1": normal(ks[13], (DEPTH, CMP_LEN, NSA_HD, CMP_HIDDEN), (CMP_LEN * NSA_HD) ** -0.5),
        "w_cmp_k2": normal(ks[14], (DEPTH, CMP_HIDDEN, NSA_HD), CMP_HIDDEN ** -0.5),
        "w_cmp_v1": normal(ks[15], (DEPTH, CMP_LEN, NSA_HD, CMP_HIDDEN), (CMP_LEN * NSA_HD) ** -0.5),
        "w_cmp_v2": normal(ks[16], (DEPTH, CMP_HIDDEN, NSA_HD), CMP_HIDDEN ** -0.5),
        "w_mem_kv": normal(ks[17], (DEPTH, D_MODEL, 2 * MEM_HEADS * MEM_HD), D_MODEL ** -0.5),
        "mem_q_norm": 1.0 + normal(ks[18], (DEPTH, MEM_HD), 0.02),
        "mem_k_norm": 1.0 + normal(ks[19], (DEPTH, MEM_HD), 0.02),
        "w_branch": normal(ks[20], (DEPTH, N_BRANCH, BRANCH_WIDTH, D_MODEL), BRANCH_WIDTH ** -0.5),
        "w_out": normal(ks[21], (DEPTH, D_MODEL, D_MODEL), D_MODEL ** -0.5),
    }


def reference(x, mem, positions, norm_gain, mem_norm_gain, w_in, w_gla_alpha, b_gla_alpha,
              gla_out_norm, nsa_q_norm, nsa_k_norm, pe_cmp_k, pe_cmp_v, w_cmp_k1, w_cmp_k2,
              w_cmp_v1, w_cmp_v2, w_mem_kv, mem_q_norm, mem_k_norm, w_branch, w_out):
    h = x
    for l in range(DEPTH):
        h = hybrid_layer(h, mem, positions, norm_gain[l], mem_norm_gain[l], w_in[l], w_gla_alpha[l],
                         b_gla_alpha[l], gla_out_norm[l], nsa_q_norm[l], nsa_k_norm[l], pe_cmp_k[l],
                         pe_cmp_v[l], w_cmp_k1[l], w_cmp_k2[l], w_cmp_v1[l], w_cmp_v2[l], w_mem_kv[l],
                         mem_q_norm[l], mem_k_norm[l], w_branch[l], w_out[l])
    return h
```

```cpp
#include <hip/hip_runtime.h>
#include <hip/hip_cooperative_groups.h>
#include <cstdio>
#include <cstdint>
namespace cg = cooperative_groups;

constexpr int NB = 2, SEQ = 8192, DM = 1024, M = NB * SEQ;
constexpr int DIN = 11840;
constexpr int C_GQ = 0, C_GK = 512, C_GV = 1024, C_LR = 2048, C_GG = 2064, C_NQ = 3088, C_NKV = 4112, C_NG = 5648,
              C_NGATE = 5696, C_MQ = 6720, C_MGATE = 7744, C_MERGE = 8768;
constexpr int NMEM = 256, NCMP = 511;
constexpr float EPS = 1e-6f;
constexpr int NTHREADS = 512, NWAVES = 8;
constexpr int LDS_BYTES = 147456;

constexpr size_t MiB = 1u << 20;
constexpr size_t WS_SM = 1 * MiB;
constexpr size_t WS_COS = 5 * MiB;
constexpr size_t WS_SIN = 7 * MiB;
constexpr size_t WS_KC = 9 * MiB;
constexpr size_t WS_VC = 11 * MiB;
constexpr size_t WS_MK = 13 * MiB;
constexpr size_t WS_MV = 15 * MiB;
constexpr size_t WS_RSTD = 17 * MiB;
constexpr size_t WS_MEMN = 18 * MiB;
constexpr size_t WS_GQK = 20 * MiB;
constexpr size_t WS_GV = 52 * MiB;
constexpr size_t WS_NQ = 84 * MiB;
constexpr size_t WS_NKV = 116 * MiB;
constexpr size_t WS_MQ = 164 * MiB;
constexpr size_t WS_END = 196 * MiB;
constexpr size_t WS_MKB = WS_KC + 1 * MiB;
constexpr size_t WS_MVT = WS_VC + 1 * MiB;

typedef unsigned short bf16_t;
__device__ __forceinline__ float bf2f(bf16_t v) { return __uint_as_float(((unsigned)v) << 16); }
__device__ __forceinline__ bf16_t f2bf(float f) { unsigned u = __float_as_uint(f); return (bf16_t)((u + 0x7fffu + ((u >> 16) & 1u)) >> 16); }
__device__ __forceinline__ float wave_sum(float v) {
#pragma unroll
    for (int o = 1; o < 64; o <<= 1) v += __shfl_xor(v, o);
    return v;
}
__device__ __forceinline__ float wave_max(float v) {
#pragma unroll
    for (int o = 1; o < 64; o <<= 1) v = fmaxf(v, __shfl_xor(v, o));
    return v;
}
__device__ __forceinline__ float sigmoidf_(float x) { return 1.f / (1.f + expf(-x)); }
__device__ __forceinline__ float fsig(float x) { return __builtin_amdgcn_rcpf(1.f + __builtin_amdgcn_exp2f(-1.4426950408889634f * x)); }
__device__ __forceinline__ float fsilu(float x) { return x * fsig(x); }

struct Params {
    const float* x; const float* mem; const int* pos; const float* norm_gain; const float* mem_norm_gain; const float* w_in;
    const float* w_alpha; const float* b_alpha; const float* gla_out_norm; const float* nsa_q_norm; const float* nsa_k_norm;
    const float* pe_k; const float* pe_v; const float* wk1; const float* wk2; const float* wv1; const float* wv2;
    const float* w_mem_kv; const float* mem_q_norm; const float* mem_k_norm; const float* w_branch; const float* w_out;
    float* out; unsigned char* ws;
};


constexpr int R_E = 0;
constexpr int R_SMALL = 5632;
constexpr int R_MKV = 5888;
constexpr int R_G = 7936;
constexpr int R_M = 11008;
constexpr int R_B = 14080;
constexpr int R_O = 17152;
constexpr int R_END = 18176;
constexpr size_t WS_BT = 196 * MiB;
constexpr size_t WS_END2 = WS_BT + (size_t)R_END * 1024 * 2;
static_assert(WS_END2 <= 256 * MiB, "workspace map");
constexpr size_t WS_UK = 232 * MiB;
constexpr size_t OUT_UV = 33 * MiB;
constexpr size_t WS_H1 = 248 * MiB;
constexpr size_t WS_W2T = 254 * MiB;
constexpr size_t WS_BTC = 252 * MiB;
static_assert(WS_END2 <= WS_UK, "workspace map");
constexpr size_t WS_GSCR = WS_NKV;

#define LAS __attribute__((address_space(3)))
typedef float f32x4 __attribute__((ext_vector_type(4)));
typedef unsigned u32x4 __attribute__((ext_vector_type(4)));
typedef unsigned u32x2 __attribute__((ext_vector_type(2)));

namespace pg8 {
#define PG8_LAS __attribute__((address_space(3)))
typedef unsigned short bf16_t;
typedef short bf16x8 __attribute__((ext_vector_type(8)));
typedef float f32x4 __attribute__((ext_vector_type(4)));
typedef unsigned u32x4 __attribute__((ext_vector_type(4)));
constexpr int BM = 256, BK = 64, HALF = 128, HTB = HALF * BK * 2  , STAGE_BYTES = 8 * HTB, NXCD = 8, WGM = 8;

__host__ __device__ __forceinline__ int lds_byte(int r, int c) { const int st = (r >> 4) * 2 + (c >> 5), rr = r & 15, cc = c & 31, ob = rr * 64 + cc * 2; return st * 1024 + (ob ^ (((ob >> 9) & 1) << 5)); }
__host__ __device__ __forceinline__ void stage_rc(int b, int& R, int& C) { const int st = b / 1024, sb = b % 1024, swz = sb ^ (((sb >> 9) & 1) << 5); R = (st >> 1) * 16 + swz / 64; C = (st & 1) * 32 + (swz % 64) / 2; }
__host__ __device__ __forceinline__ int perm32(int rho) { const int n = rho >> 4, i = rho & 15; return 8 * (i >> 2) + 4 * n + (i & 3); }

struct Unit { int pm, pn, tag; };
struct Gemm { int K; };
typedef float f32x2_cv __attribute__((ext_vector_type(2))); typedef __bf16 bf16x2_cv __attribute__((ext_vector_type(2)));
__device__ __forceinline__ unsigned cvt_pk_bf16(float lo, float hi) { const f32x2_cv v = {lo, hi}; return __builtin_bit_cast(unsigned, __builtin_convertvector(v, bf16x2_cv)); }
template <class Epi, class Sched, bool ALIGN_EPI = false, bool SP2 = false>
__device__ __forceinline__ void gemm_phase(PG8_LAS unsigned char* lds, const Gemm g, const Sched& S, const Epi& E) {
    int tid_ = threadIdx.x; asm volatile("" : "+v"(tid_));
    const int tid = tid_, wid = __builtin_amdgcn_readfirstlane(tid >> 6), lane = tid & 63, wr = wid >> 2, wc = wid & 3, fr = lane & 15, fq = lane >> 4;
    const int K = g.K, nt = K / BK;
    unsigned voffA[2], voffB[2];
#pragma unroll
    for (int i = 0; i < 2; ++i) { int R, C; stage_rc(tid * 16 + i * 8192, R, C); const int Rb = Epi::PERM ? ((R & ~31) + perm32(R & 31)) : R;
        voffA[i] = (unsigned)(R * K + C) * 2u; voffB[i] = (unsigned)(Rb * K + C) * 2u; }
    const size_t kstep = (size_t)(BK * 2);
    const size_t hstep = (size_t)HALF * K * 2;
    const size_t tstep = 2 * hstep;
    const unsigned ldsw = (unsigned)wid * 1024u;
    const int aoff = lds_byte(wr * 64 + fr, fq * 8), boff = lds_byte(wc * 32 + fr, fq * 8);
#define PG8_SA(b, h) (((b) * 2 + (h)) * HTB)
#define PG8_SB(b, h) ((4 + (b) * 2 + (h)) * HTB)
#define PG8_STAGE(bufoff, gbase, voff) do { _Pragma("unroll") for (int _i = 0; _i < 2; ++_i) \
        __builtin_amdgcn_global_load_lds((const unsigned*)((const char*)(gbase) + (voff)[_i]), (PG8_LAS unsigned*)(lds + (bufoff) + ldsw + _i * 8192), 16, 0, 0); } while (0)
#define PG8_LDA(dst, b, h) do { _Pragma("unroll") for (int m = 0; m < 4; ++m) _Pragma("unroll") for (int k = 0; k < 2; ++k) dst[m][k] = *(const PG8_LAS bf16x8*)(lds + PG8_SA(b, h) + aoff + m * 2048 + k * 1024); } while (0)
#define PG8_LDB(dst, b, h) do { _Pragma("unroll") for (int n = 0; n < 2; ++n) _Pragma("unroll") for (int k = 0; k < 2; ++k) dst[n][k] = *(const PG8_LAS bf16x8*)(lds + PG8_SB(b, h) + boff + n * 2048 + k * 1024); } while (0)
#define PG8_MMA(ai, bj, At, Bt) do { __builtin_amdgcn_s_setprio(1); _Pragma("unroll") for (int m = 0; m < 4; ++m) _Pragma("unroll") for (int n = 0; n < 2; ++n) _Pragma("unroll") for (int k = 0; k < 2; ++k) \
        acc[ai][bj][m][n] = __builtin_amdgcn_mfma_f32_16x16x32_bf16(Bt[n][k], At[m][k], acc[ai][bj][m][n], 0, 0, 0); __builtin_amdgcn_s_setprio(0); } while (0)
#define PG8_WAIT_V(n) asm volatile("s_waitcnt vmcnt(" #n ")" ::: "memory")
#define PG8_WAIT_L(n) asm volatile("s_waitcnt lgkmcnt(" #n ")" ::: "memory")
#define PG8_BAR __builtin_amdgcn_s_barrier()
#define PG8_SCHED __builtin_amdgcn_sched_barrier(0)
    Unit cur, nxt; int ui = 0;
    if (!S.next(0, cur)) return;
    f32x4 acc[2][2][4][2];
#pragma unroll
    for (int a = 0; a < 2; ++a)
#pragma unroll
        for (int b = 0; b < 2; ++b)
#pragma unroll
            for (int m = 0; m < 4; ++m)
#pragma unroll
                for (int n = 0; n < 2; ++n) acc[a][b][m][n] = (f32x4){0.f, 0.f, 0.f, 0.f};
    bf16x8 At[4][2], B0[2][2], B1[2][2];
    const char* cA = S.pa(cur); const char* cB = S.pb(cur);
    S.a_ready(cur);
    if constexpr (SP2) {
        PG8_STAGE(PG8_SB(0, 0), cB, voffB); PG8_STAGE(PG8_SB(0, 1), cB + hstep, voffB); PG8_STAGE(PG8_SA(0, 0), cA, voffA); PG8_STAGE(PG8_SA(0, 1), cA + hstep, voffA);
        if (wr == 1) PG8_BAR;
        PG8_WAIT_V(2); PG8_BAR;
        PG8_STAGE(PG8_SB(1, 0), cB + kstep, voffB); PG8_STAGE(PG8_SA(1, 0), cA + kstep, voffA); PG8_STAGE(PG8_SB(1, 1), cB + hstep + kstep, voffB);
        PG8_WAIT_V(6); PG8_BAR;
    } else {
        PG8_STAGE(PG8_SB(0, 0), cB, voffB); PG8_STAGE(PG8_SA(0, 0), cA, voffA); PG8_STAGE(PG8_SB(0, 1), cB + hstep, voffB); PG8_STAGE(PG8_SA(0, 1), cA + hstep, voffA);
        if (wr == 1) PG8_BAR;
        PG8_WAIT_V(4); PG8_BAR;
        PG8_STAGE(PG8_SB(1, 0), cB + kstep, voffB); PG8_STAGE(PG8_SA(1, 0), cA + kstep, voffA); PG8_STAGE(PG8_SB(1, 1), cB + hstep + kstep, voffB);
        PG8_WAIT_V(6); PG8_BAR;
    }
    for (;;) {
        const bool has_next = S.next(ui + 1, nxt);
        const char* nA = has_next ? S.pa(nxt) : cA; const char* nB = has_next ? S.pb(nxt) : cB;
        for (int t = 0; t < nt; t += 2) {
            const bool last = (t == nt - 2);
            const char* a1 = cA + (size_t)(t + 1) * kstep;
            const char* a2 = last ? nA : cA + (size_t)(t + 2) * kstep; const char* b2 = last ? nB : cB + (size_t)(t + 2) * kstep;
            const char* a3 = a2 + kstep; const char* b3 = b2 + kstep;
            if (last && has_next) S.a_ready(nxt);
            if constexpr (SP2) {
            PG8_LDB(B0, 0, 0); PG8_LDB(B1, 0, 1); PG8_SCHED; PG8_LDA(At, 0, 0); PG8_STAGE(PG8_SA(1, 1), a1 + hstep, voffA);
            PG8_WAIT_V(8); PG8_WAIT_L(0); PG8_BAR; PG8_MMA(0, 0, At, B0); PG8_MMA(0, 1, At, B1); PG8_BAR; PG8_SCHED;
            PG8_LDA(At, 0, 1); PG8_STAGE(PG8_SB(0, 0), b2, voffB); PG8_STAGE(PG8_SB(0, 1), b2 + hstep, voffB); PG8_STAGE(PG8_SA(0, 0), a2, voffA);
            PG8_WAIT_V(8); PG8_WAIT_L(0); PG8_BAR; PG8_MMA(1, 0, At, B0); PG8_MMA(1, 1, At, B1); PG8_BAR; PG8_SCHED;
            PG8_LDB(B0, 1, 0); PG8_LDB(B1, 1, 1); PG8_SCHED; PG8_LDA(At, 1, 0); PG8_STAGE(PG8_SA(0, 1), a2 + hstep, voffA);
            PG8_WAIT_V(8); PG8_WAIT_L(0); PG8_BAR; PG8_MMA(0, 0, At, B0); PG8_MMA(0, 1, At, B1); PG8_BAR; PG8_SCHED;
            PG8_LDA(At, 1, 1); PG8_STAGE(PG8_SB(1, 0), b3, voffB); PG8_STAGE(PG8_SB(1, 1), b3 + hstep, voffB); PG8_STAGE(PG8_SA(1, 0), a3, voffA);
            PG8_WAIT_V(8); PG8_WAIT_L(0); PG8_BAR; PG8_MMA(1, 0, At, B0); PG8_MMA(1, 1, At, B1); PG8_BAR; PG8_SCHED;
            } else {
            PG8_LDB(B0, 0, 0); PG8_SCHED; PG8_LDA(At, 0, 0); PG8_STAGE(PG8_SA(1, 1), a1 + hstep, voffA);
            PG8_WAIT_L(8); PG8_BAR; PG8_WAIT_L(0); PG8_MMA(0, 0, At, B0); PG8_BAR; PG8_SCHED;
            PG8_LDB(B1, 0, 1); PG8_STAGE(PG8_SB(0, 0), b2, voffB);
            PG8_BAR; PG8_WAIT_L(0); PG8_MMA(0, 1, At, B1); PG8_BAR;
            PG8_LDA(At, 0, 1); PG8_STAGE(PG8_SA(0, 0), a2, voffA);
            PG8_BAR; PG8_WAIT_L(0); PG8_MMA(1, 0, At, B0); PG8_BAR; PG8_SCHED;
            PG8_STAGE(PG8_SB(0, 1), b2 + hstep, voffB);
            PG8_WAIT_V(6); PG8_BAR; PG8_MMA(1, 1, At, B1); PG8_BAR;
            PG8_LDB(B0, 1, 0); PG8_SCHED; PG8_LDA(At, 1, 0); PG8_STAGE(PG8_SA(0, 1), a2 + hstep, voffA);
            PG8_WAIT_L(8); PG8_BAR; PG8_WAIT_L(0); PG8_MMA(0, 0, At, B0); PG8_BAR; PG8_SCHED;
            PG8_LDB(B1, 1, 1); PG8_STAGE(PG8_SB(1, 0), b3, voffB);
            PG8_BAR; PG8_WAIT_L(0); PG8_MMA(0, 1, At, B1); PG8_BAR;
            PG8_LDA(At, 1, 1); PG8_STAGE(PG8_SA(1, 0), a3, voffA);
            PG8_BAR; PG8_WAIT_L(0); PG8_MMA(1, 0, At, B0); PG8_BAR; PG8_SCHED;
            PG8_STAGE(PG8_SB(1, 1), b3 + hstep, voffB);
            PG8_WAIT_V(6); PG8_BAR; PG8_MMA(1, 1, At, B1); PG8_BAR;
            }
        }
        if constexpr (ALIGN_EPI) { if (wr == 0) PG8_BAR; }
        if constexpr (!Epi::AFTER_DRAIN) { E(acc, cur, wr, wc, fr, fq); S.done(cur); }
        if (!has_next) break;
#pragma unroll
        for (int a = 0; a < 2; ++a)
#pragma unroll
            for (int b = 0; b < 2; ++b)
#pragma unroll
                for (int m = 0; m < 4; ++m)
#pragma unroll
                    for (int n = 0; n < 2; ++n) acc[a][b][m][n] = (f32x4){0.f, 0.f, 0.f, 0.f};
        cur = nxt; cA = nA; cB = nB; ++ui;
        if constexpr (ALIGN_EPI) { if (wr == 1) PG8_BAR; }
    }
    PG8_WAIT_V(0);
    if constexpr (!ALIGN_EPI) { if (wr == 0) PG8_BAR; }
    PG8_BAR;
    if constexpr (Epi::AFTER_DRAIN) { E.fused(acc, cur, wr, wc, fr, fq, lds, wid, lane); S.done(cur); }
#undef PG8_SA
#undef PG8_SB
#undef PG8_STAGE
#undef PG8_LDA
#undef PG8_LDB
#undef PG8_MMA
#undef PG8_WAIT_V
#undef PG8_WAIT_L
#undef PG8_BAR
#undef PG8_SCHED
}
}

#define RLX_AGENT __ATOMIC_RELAXED, __HIP_MEMORY_SCOPE_AGENT
#define XB_TMO      128
#define XB_XCNT(j)  (256  + 64 * (j))
#define XB_XSUB(j)  (1280 + 64 * (j))
#define XB_XGEN(j)  (2304 + 64 * (j))
#define XB_TOP      3328
#define XB_TOPGEN   3392
#define XCD_BAR_WORDS 3456
#define XB_SPIN_CAP (1u << 18)

__device__ __forceinline__ unsigned xb_ld(unsigned* p)              { return __hip_atomic_load(p, __ATOMIC_RELAXED, __HIP_MEMORY_SCOPE_AGENT); }
__device__ __forceinline__ unsigned xb_add(unsigned* p, unsigned v) { return __hip_atomic_fetch_add(p, v, __ATOMIC_RELAXED, __HIP_MEMORY_SCOPE_AGENT); }
__device__ __forceinline__ unsigned xb_xcc_id() { return (unsigned)__builtin_amdgcn_s_getreg((3 << 11) | 20) & 0xFu; }
#define XB_SPIN(cond, bar) do { unsigned _sp = 0; while (cond) { __builtin_amdgcn_s_sleep(1); \
    if ((++_sp & 255u) == 0u) { if (xb_ld(&(bar)[XB_TMO])) break; if (_sp > XB_SPIN_CAP) { atomicAdd(&(bar)[XB_TMO], 1u); break; } } } } while (0)

struct XcdBarrier {
    unsigned* bar; unsigned x;
    volatile LAS unsigned* st;
};

__device__ __forceinline__ XcdBarrier xcd_barrier_post(unsigned* bar, volatile LAS unsigned* st) {
    XcdBarrier b; b.bar = bar; b.x = xb_xcc_id(); b.st = st;
    if (threadIdx.x == 0) (void)xb_add(&bar[XB_XCNT(b.x)], 1u);
    return b;
}
__device__ __forceinline__ void xcd_barrier_complete(unsigned* bar, unsigned x, unsigned& nloc, unsigned& nx) {
    const unsigned G = gridDim.x * gridDim.y * gridDim.z;
    unsigned sum, cnt, mine, sp = 0u;
    for (;;) {
        sum = 0u; cnt = 0u; mine = 0u;
#pragma unroll
        for (unsigned j = 0; j < 16; ++j) { const unsigned c = xb_ld(&bar[XB_XCNT(j)]); sum += c; cnt += (c > 0u) ? 1u : 0u; mine = (j == x) ? c : mine; }
        if (sum == G) break;
        __builtin_amdgcn_s_sleep(1);
        if ((++sp & 255u) == 0u) { if (xb_ld(&bar[XB_TMO])) break; if (sp > XB_SPIN_CAP) { atomicAdd(&bar[XB_TMO], 1u); break; } }
    }
    nloc = mine > 0u ? mine : 1u; nx = cnt > 0u ? cnt : 1u;
}

__device__ __forceinline__ void xcd_barrier(const XcdBarrier& b) {
    asm volatile("s_waitcnt vmcnt(0)" ::: "memory");
    __syncthreads();
    if (threadIdx.x == 0) {
        unsigned* bar = b.bar;
        __builtin_amdgcn_s_waitcnt(0);
        unsigned nloc = b.st[0], nx = b.st[1];
        if (nloc == 0u) { xcd_barrier_complete(bar, b.x, nloc, nx); b.st[0] = nloc; b.st[1] = nx; }
        const unsigned old = xb_add(&bar[XB_XSUB(b.x)], 1u);
        const unsigned gen = old / nloc;
        if (old + 1u == (gen + 1u) * nloc) {
            __builtin_amdgcn_fence(__ATOMIC_RELEASE, "agent");
            asm volatile("s_waitcnt vmcnt(0)" ::: "memory");
            const unsigned og = xb_add(&bar[XB_TOP], 1u);
            const unsigned tg = og / nx;
            if (og + 1u == (tg + 1u) * nx) xb_add(&bar[XB_TOPGEN], 1u);
            else XB_SPIN(xb_ld(&bar[XB_TOPGEN]) == tg, bar);
            __builtin_amdgcn_fence(__ATOMIC_ACQUIRE, "agent");
            xb_add(&bar[XB_XGEN(b.x)], 1u);
            asm volatile("s_waitcnt vmcnt(0)" ::: "memory");
        } else {
            XB_SPIN(xb_ld(&bar[XB_XGEN(b.x)]) == gen, bar);
            __builtin_amdgcn_fence(__ATOMIC_ACQUIRE, "agent");
            asm volatile("s_waitcnt vmcnt(0)" ::: "memory");
        }
    }
    __syncthreads();
}

struct SchedEarly {
    const char* A; const char* B; int G, c;
    static constexpr int nM = 64, nN = 23, nwg = nM * nN, nx = 16;
    __device__ __forceinline__ bool next(int i, pg8::Unit& u) const {
        const int L = i * G + c; if (L >= nwg + nx) return false;
        if (L >= nwg) { const int e = L - nwg; u.pm = 64 + (e >> 3); u.pn = 23 + (e & 7); u.tag = 1; return true; }
        int wgid = L; { const int q = nwg / 8, xcd = wgid % 8, off = wgid / 8; wgid = xcd * q + off; }
        const int nig = 8 * nN, gid = wgid / nig, fm = gid * 8;
        const int s = (wgid % nig) / 8;
        const unsigned long long tab = s < 12 ? 0x5a928398a418820ull : 0x5272ada2f6c1ccull;
        u.pm = fm + ((wgid % nig) % 8); u.pn = (int)((tab >> (5 * (s < 12 ? s : s - 12))) & 31u); u.tag = 0; return true;
    }
    __device__ __forceinline__ const char* pa(const pg8::Unit& u) const { return A + (size_t)u.pm * (256 * 1024 * 2); }
    __device__ __forceinline__ const char* pb(const pg8::Unit& u) const { return B + (size_t)u.pn * (256 * 1024 * 2); }
    __device__ __forceinline__ void a_ready(const pg8::Unit&) const {}
    __device__ __forceinline__ void done(const pg8::Unit&) const {}
};
struct SchedPlain {
    const char* A; const char* B; int nN, nwg, G, c;
    __device__ __forceinline__ bool next(int i, pg8::Unit& u) const {
        const int L = i * G + c; if (L >= nwg) return false;
        int wgid = L; { const int q = nwg / 8, xcd = wgid % 8, off = wgid / 8; wgid = xcd * q + off; }
        const int nig = 8 * nN, gid = wgid / nig, fm = gid * 8;
        u.pm = fm + ((wgid % nig) % 8); u.pn = (wgid % nig) / 8; u.tag = 0; return true;
    }
    __device__ __forceinline__ const char* pa(const pg8::Unit& u) const { return A + (size_t)u.pm * (256 * 1024 * 2); }
    __device__ __forceinline__ const char* pb(const pg8::Unit& u) const { return B + (size_t)u.pn * (256 * 1024 * 2); }
    __device__ __forceinline__ void a_ready(const pg8::Unit&) const {}
    __device__ __forceinline__ void done(const pg8::Unit&) const {}
};
struct SchedMix {
    const char* XN; const char* Y0; const char* Y1; const char* Y2; const char* BM_; const char* BB; int G, c;
    __device__ __forceinline__ bool next(int i, pg8::Unit& u) const {
        const int tl = (i / 6) * G + c; if (tl >= 256) return false;
        int wgid = tl; { const int xcd = wgid % 8, off = wgid / 8; wgid = xcd * 32 + off; }
        const int gid = wgid / 32, fm = gid * 8;
        u.pm = fm + ((wgid % 32) % 8); u.pn = (wgid % 32) / 8; u.tag = i % 6; return true;
    }
    __device__ __forceinline__ const char* pa(const pg8::Unit& u) const {
        const int cc = u.tag >> 1; const char* base = (u.tag & 1) ? (cc == 0 ? Y0 : (cc == 1 ? Y1 : Y2)) : XN;
        return base + (size_t)u.pm * (256 * 1024 * 2); }
    __device__ __forceinline__ const char* pb(const pg8::Unit& u) const {
        const int cc = u.tag >> 1; return ((u.tag & 1) ? BB : BM_) + (size_t)(cc * 4 + u.pn) * (256 * 1024 * 2); }
    __device__ __forceinline__ void a_ready(const pg8::Unit&) const {}
    __device__ __forceinline__ void done(const pg8::Unit&) const {}
};

__device__ __forceinline__ float fq_sum(float x) {
    const auto r = __builtin_amdgcn_permlane16_swap(__float_as_uint(x), __float_as_uint(x), false, false);
    const float s = __uint_as_float(r[0]) + __uint_as_float(r[1]);
    const auto q = __builtin_amdgcn_permlane32_swap(__float_as_uint(s), __float_as_uint(s), false, false);
    return __uint_as_float(q[0]) + __uint_as_float(q[1]);
}
struct EpiEarly {
    static constexpr bool PERM = true, AFTER_DRAIN = false;
    unsigned char* ws; PG8_LAS unsigned char* lds; bf16_t* UV;
    const float* nsa_q_norm; const float* nsa_k_norm; const float* pe_k; const float* pe_v; const float* mem_q_norm; const float* mem_k_norm;
    static constexpr int XS = 131072;
    __device__ __forceinline__ void operator()(const pg8::f32x4 (&acc)[2][2][4][2], const pg8::Unit& u, int wr, int wc, int fr_, int fq_) const {
        int fr = fr_, fq = fq_; asm volatile("" : "+v"(fr), "+v"(fq));
        const int pn = u.pn;
        const bool headtile = (pn >= 8 && pn < 15) || pn == 16;
        if (pn < 8 || pn == 15 || pn == 17) {
            bf16_t* base; int ldc = 1024, colt; float sc = 1.f;
            if (pn < 4) { base = (bf16_t*)(ws + WS_GQK); colt = pn * 256; if (pn < 2) sc = 0.08838834764831845f; }
            else if (pn < 8) { base = (bf16_t*)(ws + WS_GV); colt = (pn - 4) * 256; }
            else { base = (bf16_t*)(ws + WS_NKV); colt = (pn - 12) * 256; ldc = 1536; }
            const int row0 = u.pm * 256 + wr * 64 + fr, col0 = colt + wc * 32 + 8 * fq;
#pragma unroll
            for (int ai = 0; ai < 2; ++ai)
#pragma unroll
                for (int m = 0; m < 4; ++m) { bf16_t* rowp = base + (size_t)(row0 + ai * 128 + m * 16) * ldc + col0;
#pragma unroll
                    for (int bj = 0; bj < 2; ++bj) { const pg8::f32x4 v0 = acc[ai][bj][m][0] * sc, v1 = acc[ai][bj][m][1] * sc; u32x4 w;
                        w.x = pg8::cvt_pk_bf16(v0[0], v0[1]); w.y = pg8::cvt_pk_bf16(v0[2], v0[3]); w.z = pg8::cvt_pk_bf16(v1[0], v1[1]); w.w = pg8::cvt_pk_bf16(v1[2], v1[3]);
                        *(u32x4*)(rowp + bj * 128) = w; } }
        } else if (headtile) {
            const bool isq = pn < 12, isv = pn == 13, iscmp = (pn == 12 || pn == 13);
            const float* gn = isq ? nsa_q_norm : (nsa_k_norm + ((pn - 12) >> 1) * 64);
            const float osc = isq ? 0.125f * 1.4426950408889634f : 1.f;
            float ga[8], gb[8];
            { const f32x4 g0 = *(const f32x4*)(gn + 8 * fq), g1 = *(const f32x4*)(gn + 8 * fq + 4), g2 = *(const f32x4*)(gn + 32 + 8 * fq), g3 = *(const f32x4*)(gn + 36 + 8 * fq);
#pragma unroll
              for (int e = 0; e < 4; ++e) { ga[e] = g0[e] * osc; ga[4 + e] = g1[e] * osc; gb[e] = g2[e] * osc; gb[4 + e] = g3[e] * osc; } }
            const float* COS = (const float*)(ws + WS_COS); const float* SIN = (const float*)(ws + WS_SIN);
            bf16_t* obase = isq ? ((bf16_t*)(ws + WS_NQ) + (pn - 8) * 256) : ((bf16_t*)(ws + WS_NKV) + (pn - 12) * 256);
            const int ldc = isq ? 1024 : 1536;
            bf16_t* U = isv ? UV : (bf16_t*)(ws + WS_UK); const float* pe = isv ? pe_v : pe_k;
            const int row0 = u.pm * 256 + wr * 64 + fr;
            f32x4 tb[2][4];
#define EE_LDT(r, d) do { const size_t to_ = (size_t)(row0 + ((r) >> 2) * 128 + ((r) & 3) * 16) * 32 + 8 * fq; d[0] = *(const f32x4*)(COS + to_); d[1] = *(const f32x4*)(COS + to_ + 4); d[2] = *(const f32x4*)(SIN + to_); d[3] = *(const f32x4*)(SIN + to_ + 4); } while (0)
            if (!isv) EE_LDT(0, tb[0]);
#pragma unroll
            for (int r = 0; r < 8; ++r) {
                    const int ai = r >> 2, m = r & 3;
                    const int t = row0 + ai * 128 + m * 16;
                    if (!isv && r < 7) EE_LDT(r + 1, tb[(r + 1) & 1]);
                    const pg8::f32x4 x0 = acc[ai][0][m][0], x1 = acc[ai][0][m][1], y0 = acc[ai][1][m][0], y1 = acc[ai][1][m][1];
                    float a[8] = {x0[0], x0[1], x0[2], x0[3], x1[0], x1[1], x1[2], x1[3]};
                    float b[8] = {y0[0], y0[1], y0[2], y0[3], y1[0], y1[1], y1[2], y1[3]};
                    if (!isv) {
                        float ss = 0.f;
#pragma unroll
                        for (int e = 0; e < 8; ++e) ss += a[e] * a[e] + b[e] * b[e];
                        const float rs = rsqrtf(fq_sum(ss) * (1.f / 64.f) + EPS);
                        const f32x4 c0 = tb[r & 1][0], c1 = tb[r & 1][1], s0 = tb[r & 1][2], s1 = tb[r & 1][3];
#pragma unroll
                        for (int e = 0; e < 8; ++e) { const float cc = (e < 4 ? c0[e & 3] : c1[e & 3]) * rs, sn = (e < 4 ? s0[e & 3] : s1[e & 3]) * rs;
                            const float ya = a[e] * ga[e], yb = b[e] * gb[e]; a[e] = ya * cc - yb * sn; b[e] = yb * cc + ya * sn; }
                    }
                    if (!iscmp) {
                        bf16_t* op = obase + (size_t)t * ldc + wc * 64 + 8 * fq; u32x4 oa, ob;
                        oa.x = pg8::cvt_pk_bf16(a[0], a[1]); oa.y = pg8::cvt_pk_bf16(a[2], a[3]); oa.z = pg8::cvt_pk_bf16(a[4], a[5]); oa.w = pg8::cvt_pk_bf16(a[6], a[7]);
                        ob.x = pg8::cvt_pk_bf16(b[0], b[1]); ob.y = pg8::cvt_pk_bf16(b[2], b[3]); ob.z = pg8::cvt_pk_bf16(b[4], b[5]); ob.w = pg8::cvt_pk_bf16(b[6], b[7]);
                        *(u32x4*)op = oa; *(u32x4*)(op + 32) = ob;
                    } else {
                        const int bb = t / SEQ, ts = t % SEQ, n1 = ts >> 4;
#pragma unroll
                        for (int rep = 0; rep < 2; ++rep) {
                            const int n = n1 - rep, ll = fr + 16 * rep;
                            if (n >= 0 && n < NCMP) {
                                const float* pp = pe + ll * 64 + 8 * fq;
                                const f32x4 pa0 = *(const f32x4*)pp, pa1 = *(const f32x4*)(pp + 4), pb0 = *(const f32x4*)(pp + 32), pb1 = *(const f32x4*)(pp + 36);
                                u32x4 oa, ob;
                                oa.x = pg8::cvt_pk_bf16(a[0] + pa0[0], a[1] + pa0[1]); oa.y = pg8::cvt_pk_bf16(a[2] + pa0[2], a[3] + pa0[3]); oa.z = pg8::cvt_pk_bf16(a[4] + pa1[0], a[5] + pa1[1]); oa.w = pg8::cvt_pk_bf16(a[6] + pa1[2], a[7] + pa1[3]);
                                ob.x = pg8::cvt_pk_bf16(b[0] + pb0[0], b[1] + pb0[1]); ob.y = pg8::cvt_pk_bf16(b[2] + pb0[2], b[3] + pb0[3]); ob.z = pg8::cvt_pk_bf16(b[4] + pb1[0], b[5] + pb1[1]); ob.w = pg8::cvt_pk_bf16(b[6] + pb1[2], b[7] + pb1[3]);
                                bf16_t* up = U + ((size_t)(bb * NCMP + n) * 4 + wc) * 2048 + ll * 64 + 8 * fq;
                                *(u32x4*)up = oa; *(u32x4*)(up + 32) = ob;
                            }
                        }
                    }
            }
#undef EE_LDT
        } else if (pn == 22) {
            if (wc < 2) { float* SM = (float*)(ws + WS_SM); const int row0 = u.pm * 256 + wr * 64 + fr, col0 = wc * 32 + 8 * fq;
#pragma unroll
                for (int ai = 0; ai < 2; ++ai)
#pragma unroll
                    for (int m = 0; m < 4; ++m) { float* rowp = SM + (size_t)(row0 + ai * 128 + m * 16) * 64 + col0;
                        *(pg8::f32x4*)(rowp) = acc[ai][0][m][0]; *(pg8::f32x4*)(rowp + 4) = acc[ai][0][m][1]; } }
        } else if (pn >= 27) {
            bf16_t* MVT = (bf16_t*)(ws + WS_MVT) + (size_t)((u.pm - 64) * 4 + (pn - 27)) * 65536;
            const int m0 = wr * 64 + fr, d0 = wc * 32 + 8 * fq;
#pragma unroll
            for (int ai = 0; ai < 2; ++ai)
#pragma unroll
                for (int m = 0; m < 4; ++m)
#pragma unroll
                    for (int bj = 0; bj < 2; ++bj)
#pragma unroll
                        for (int e = 0; e < 8; ++e) MVT[(size_t)(d0 + bj * 128 + e) * 256 + m0 + ai * 128 + m * 16] = f2bf(acc[ai][bj][m][e >> 2][e & 3]);
        } else {
            const bool isk = pn >= 23;
            PG8_LAS float* xs = (PG8_LAS float*)(lds + XS) + wr * 512;
            float ssr[8];
#pragma unroll
            for (int ai = 0; ai < 2; ++ai)
#pragma unroll
                for (int m = 0; m < 4; ++m) { float ss = 0.f;
#pragma unroll
                    for (int bj = 0; bj < 2; ++bj)
#pragma unroll
                        for (int n = 0; n < 2; ++n) { const pg8::f32x4 v = acc[ai][bj][m][n]; ss += v[0] * v[0] + v[1] * v[1] + v[2] * v[2] + v[3] * v[3]; }
                    ss = fq_sum(ss);
                    if (fq == 0) xs[(ai * 64 + m * 16 + fr) * 4 + wc] = ss; }
            asm volatile("s_waitcnt lgkmcnt(0)" ::: "memory"); __builtin_amdgcn_s_barrier(); asm volatile("" ::: "memory");
#pragma unroll
            for (int ai = 0; ai < 2; ++ai)
#pragma unroll
                for (int m = 0; m < 4; ++m) { const f32x4 q4 = *(const PG8_LAS f32x4*)(xs + (ai * 64 + m * 16 + fr) * 4); ssr[ai * 4 + m] = q4[0] + q4[1] + q4[2] + q4[3]; }
            const float* gn = isk ? mem_k_norm : mem_q_norm; const float osc = isk ? 1.f : 0.0625f * 1.4426950408889634f;
            const int c0 = wc * 32 + 8 * fq;
            bf16_t* obase = isk ? ((bf16_t*)(ws + WS_MKB) + (size_t)((u.pm - 64) * 4 + (pn - 23)) * 65536) : ((bf16_t*)(ws + WS_MQ) + (size_t)u.pm * 256 * 1024 + (pn - 18) * 256);
            const int ldc = isk ? 256 : 1024;
#pragma unroll
            for (int bj = 0; bj < 2; ++bj) {
                const f32x4 g0 = *(const f32x4*)(gn + c0 + bj * 128) * osc, g1 = *(const f32x4*)(gn + c0 + bj * 128 + 4) * osc;
#pragma unroll
                for (int ai = 0; ai < 2; ++ai)
#pragma unroll
                    for (int m = 0; m < 4; ++m) { const float rs = rsqrtf(ssr[ai * 4 + m] * (1.f / 256.f) + EPS);
                        const pg8::f32x4 v0 = acc[ai][bj][m][0] * rs * g0, v1 = acc[ai][bj][m][1] * rs * g1; u32x4 w;
                        w.x = pg8::cvt_pk_bf16(v0[0], v0[1]); w.y = pg8::cvt_pk_bf16(v0[2], v0[3]); w.z = pg8::cvt_pk_bf16(v1[0], v1[1]); w.w = pg8::cvt_pk_bf16(v1[2], v1[3]);
                        *(u32x4*)(obase + (size_t)(wr * 64 + fr + ai * 128 + m * 16) * ldc + c0 + bj * 128) = w; }
            }
        }
    }
};
__device__ __forceinline__ float bflo(unsigned w) { return __uint_as_float(w << 16); }
__device__ __forceinline__ float bfhi(unsigned w) { return __uint_as_float(w & 0xffff0000u); }
struct EpiGates {
    static constexpr bool PERM = true, AFTER_DRAIN = false;
    unsigned char* ws;
    template <bool GLA>
    __device__ __forceinline__ void run(const pg8::f32x4 (&acc)[2][2][4][2], const pg8::Unit& u, int wr, int wc, int fr, int fq) const {
        const int pn = u.pn; const int br = pn >> 2;
        bf16_t* base = (bf16_t*)(ws + (GLA ? WS_GV : (br == 1 ? WS_NQ : WS_MQ)));
        const float* RSTD = (const float*)(ws + WS_RSTD);
        const int row0 = u.pm * 256 + wr * 64 + fr, col0 = (pn & 3) * 256 + wc * 32 + 8 * fq;
#pragma unroll
        for (int am = 0; am < 4; ++am) {
            const int ai = am >> 1, m0 = (am & 1) * 2;
            u32x4 ov[2][2]; f32x4 q4[2];
#pragma unroll
            for (int mm = 0; mm < 2; ++mm) { const int row = row0 + ai * 128 + (m0 + mm) * 16; const bf16_t* rowp = base + (size_t)row * 1024 + col0;
                ov[mm][0] = *(const u32x4*)rowp; ov[mm][1] = *(const u32x4*)(rowp + 128);
                if (GLA) q4[mm] = *(const f32x4*)(RSTD + (size_t)row * 16 + pn * 4); }
            __builtin_amdgcn_sched_barrier(0);
#pragma unroll
            for (int mm = 0; mm < 2; ++mm) { const int m = m0 + mm; const int row = row0 + ai * 128 + m * 16; bf16_t* rowp = base + (size_t)row * 1024 + col0;
                float rs = 1.f;
                if (GLA) rs = rsqrtf((q4[mm][0] + q4[mm][1] + q4[mm][2] + q4[mm][3]) * (1.f / 256.f) + EPS);
#pragma unroll
                for (int bj = 0; bj < 2; ++bj) { const u32x4 o = ov[mm][bj]; const pg8::f32x4 a0 = acc[ai][bj][m][0], a1 = acc[ai][bj][m][1];
                    u32x4 w;
                    w.x = pg8::cvt_pk_bf16(bflo(o.x) * rs * fsilu(a0[0]), bfhi(o.x) * rs * fsilu(a0[1]));
                    w.y = pg8::cvt_pk_bf16(bflo(o.y) * rs * fsilu(a0[2]), bfhi(o.y) * rs * fsilu(a0[3]));
                    w.z = pg8::cvt_pk_bf16(bflo(o.z) * rs * fsilu(a1[0]), bfhi(o.z) * rs * fsilu(a1[1]));
                    w.w = pg8::cvt_pk_bf16(bflo(o.w) * rs * fsilu(a1[2]), bfhi(o.w) * rs * fsilu(a1[3]));
                    *(u32x4*)(rowp + bj * 128) = w; } }
        }
    }
    __device__ __forceinline__ void operator()(const pg8::f32x4 (&acc)[2][2][4][2], const pg8::Unit& u, int wr, int wc, int fr_, int fq_) const {
        int fr = fr_, fq = fq_; asm volatile("" : "+v"(fr), "+v"(fq));
        if ((u.pn >> 2) == 0) run<true>(acc, u, wr, wc, fr, fq); else run<false>(acc, u, wr, wc, fr, fq);
    }
};
struct EpiMix {
    static constexpr bool PERM = true, AFTER_DRAIN = false;
    unsigned char* ws;
    template <bool ACCUM>
    __device__ __forceinline__ void run1(const pg8::f32x4 (&acc)[2][2][4][2], const pg8::Unit& u, int wr, int wc, int fr, int fq) const {
        const bf16_t* scr = (const bf16_t*)(ws + WS_GSCR) + (size_t)blockIdx.x * 65536;
        bf16_t* MIXED = (bf16_t*)(ws + WS_GQK);
        const int r0 = wr * 64 + fr, c0 = wc * 32 + 8 * fq;
#pragma unroll
        for (int am = 0; am < 4; ++am) {
            const int ai = am >> 1, m0 = (am & 1) * 2;
            u32x4 gv[2][2], ov[2][2];
#pragma unroll
            for (int mm = 0; mm < 2; ++mm) { const int rt = r0 + ai * 128 + (m0 + mm) * 16;
                const bf16_t* sp = scr + rt * 256 + c0; const bf16_t* mp = MIXED + (size_t)(u.pm * 256 + rt) * 1024 + u.pn * 256 + c0;
                gv[mm][0] = *(const u32x4*)sp; gv[mm][1] = *(const u32x4*)(sp + 128);
                if (ACCUM) { ov[mm][0] = *(const u32x4*)mp; ov[mm][1] = *(const u32x4*)(mp + 128); } }
            __builtin_amdgcn_sched_barrier(0);
#pragma unroll
            for (int mm = 0; mm < 2; ++mm) { const int m = m0 + mm; const int rt = r0 + ai * 128 + m * 16; bf16_t* mp = MIXED + (size_t)(u.pm * 256 + rt) * 1024 + u.pn * 256 + c0;
#pragma unroll
                for (int bj = 0; bj < 2; ++bj) { const pg8::f32x4 a0 = acc[ai][bj][m][0], a1 = acc[ai][bj][m][1]; const u32x4 g = gv[mm][bj]; u32x4 w;
                    float v[8] = {bflo(g.x) * a0[0], bfhi(g.x) * a0[1], bflo(g.y) * a0[2], bfhi(g.y) * a0[3], bflo(g.z) * a1[0], bfhi(g.z) * a1[1], bflo(g.w) * a1[2], bfhi(g.w) * a1[3]};
                    if (ACCUM) { const u32x4 o = ov[mm][bj];
                        v[0] += bflo(o.x); v[1] += bfhi(o.x); v[2] += bflo(o.y); v[3] += bfhi(o.y); v[4] += bflo(o.z); v[5] += bfhi(o.z); v[6] += bflo(o.w); v[7] += bfhi(o.w); }
                    w.x = pg8::cvt_pk_bf16(v[0], v[1]); w.y = pg8::cvt_pk_bf16(v[2], v[3]); w.z = pg8::cvt_pk_bf16(v[4], v[5]); w.w = pg8::cvt_pk_bf16(v[6], v[7]);
                    *(u32x4*)(mp + bj * 128) = w; } }
        }
    }
    __device__ __forceinline__ void operator()(const pg8::f32x4 (&acc)[2][2][4][2], const pg8::Unit& u, int wr, int wc, int fr_, int fq_) const {
        int fr = fr_, fq = fq_; asm volatile("" : "+v"(fr), "+v"(fq));
        const int kind = u.tag & 1, cc = u.tag >> 1;
        if (kind == 0) {
            bf16_t* scr = (bf16_t*)(ws + WS_GSCR) + (size_t)blockIdx.x * 65536;
            const int r0 = wr * 64 + fr, c0 = wc * 32 + 8 * fq;
#pragma unroll
            for (int ai = 0; ai < 2; ++ai)
#pragma unroll
                for (int m = 0; m < 4; ++m) { const int rt = r0 + ai * 128 + m * 16; bf16_t* sp = scr + rt * 256 + c0;
#pragma unroll
                    for (int bj = 0; bj < 2; ++bj) { const pg8::f32x4 a0 = acc[ai][bj][m][0], a1 = acc[ai][bj][m][1]; u32x4 w;
                        w.x = pg8::cvt_pk_bf16(fsig(a0[0]), fsig(a0[1])); w.y = pg8::cvt_pk_bf16(fsig(a0[2]), fsig(a0[3]));
                        w.z = pg8::cvt_pk_bf16(fsig(a1[0]), fsig(a1[1])); w.w = pg8::cvt_pk_bf16(fsig(a1[2]), fsig(a1[3]));
                        *(u32x4*)(sp + bj * 128) = w; } }
        } else if (cc == 0) run1<false>(acc, u, wr, wc, fr, fq);
        else run1<true>(acc, u, wr, wc, fr, fq);
    }
};
struct EpiOut {
    static constexpr bool PERM = false, AFTER_DRAIN = false;
    const float* x; float* out;
    __device__ __forceinline__ void operator()(const pg8::f32x4 (&acc)[2][2][4][2], const pg8::Unit& u, int wr, int wc, int fr_, int fq_) const {
        int fr = fr_, fq = fq_; asm volatile("" : "+v"(fr), "+v"(fq));
        const int row0 = u.pm * 256 + wr * 64 + fr, col0 = u.pn * 256 + wc * 32 + 4 * fq;
#pragma unroll
        for (int am = 0; am < 4; ++am) {
            const int ai = am >> 1, m0 = (am & 1) * 2;
            pg8::f32x4 xv[2][2][2];
#pragma unroll
            for (int mm = 0; mm < 2; ++mm) { const size_t off = (size_t)(row0 + ai * 128 + (m0 + mm) * 16) * 1024 + col0;
#pragma unroll
                for (int bj = 0; bj < 2; ++bj)
#pragma unroll
                    for (int n = 0; n < 2; ++n) xv[mm][bj][n] = *(const pg8::f32x4*)(x + off + bj * 128 + n * 16); }
            __builtin_amdgcn_sched_barrier(0);
#pragma unroll
            for (int mm = 0; mm < 2; ++mm) { const size_t off = (size_t)(row0 + ai * 128 + (m0 + mm) * 16) * 1024 + col0;
#pragma unroll
                for (int bj = 0; bj < 2; ++bj)
#pragma unroll
                    for (int n = 0; n < 2; ++n) *(pg8::f32x4*)(out + off + bj * 128 + n * 16) = xv[mm][bj][n] + acc[ai][bj][m0 + mm][n]; }
        }
    }
};

struct SchedCmp {
    const char* UK; const char* UV; const char* B; int u;
    __device__ __forceinline__ bool next(int i, pg8::Unit& un) const { if (i > 0) return false; un.pm = u & 15; un.pn = 0; un.tag = u >> 4; return true; }
    __device__ __forceinline__ const char* pa(const pg8::Unit& un) const { return (un.tag ? UV : UK) + (size_t)un.pm * (256 * 2048 * 2); }
    __device__ __forceinline__ const char* pb(const pg8::Unit& un) const { return B + (size_t)un.tag * (256 * 2048 * 2); }
    __device__ __forceinline__ void a_ready(const pg8::Unit&) const {}
    __device__ __forceinline__ void done(const pg8::Unit&) const {}
};
__device__ __forceinline__ float gelu_tanh_(float x) { const float u = 0.7978845608028654f * (x + 0.044715f * x * x * x); return x * fsig(2.f * u); }
struct EpiCmp {
    static constexpr bool PERM = true, AFTER_DRAIN = false;
    bf16_t* H1;
    __device__ __forceinline__ void operator()(const pg8::f32x4 (&acc)[2][2][4][2], const pg8::Unit& u, int wr, int wc, int fr, int fq) const {
        bf16_t* base = H1 + (size_t)u.tag * 4096 * 256;
        const int row0 = u.pm * 256 + wr * 64 + fr, col0 = wc * 32 + 8 * fq;
#pragma unroll
        for (int ai = 0; ai < 2; ++ai)
#pragma unroll
            for (int m = 0; m < 4; ++m) { bf16_t* rowp = base + (size_t)(row0 + ai * 128 + m * 16) * 256 + col0;
#pragma unroll
                for (int bj = 0; bj < 2; ++bj) { const pg8::f32x4 v0 = acc[ai][bj][m][0], v1 = acc[ai][bj][m][1]; u32x4 w;
                    w.x = pg8::cvt_pk_bf16(gelu_tanh_(v0[0]), gelu_tanh_(v0[1])); w.y = pg8::cvt_pk_bf16(gelu_tanh_(v0[2]), gelu_tanh_(v0[3]));
                    w.z = pg8::cvt_pk_bf16(gelu_tanh_(v1[0]), gelu_tanh_(v1[1])); w.w = pg8::cvt_pk_bf16(gelu_tanh_(v1[2]), gelu_tanh_(v1[3]));
                    *(u32x4*)(rowp + bj * 128) = w; } }
    }
};
__device__ __forceinline__ void compress_stage2(const Params& p, int u) {
    typedef short bf16x8 __attribute__((ext_vector_type(8)));
    typedef float f32x16 __attribute__((ext_vector_type(16)));
    const int tid = threadIdx.x, lane = tid & 63, wid = tid >> 6, r32 = lane & 31, hi = lane >> 5, which = u >> 4, pm = u & 15;
    const bf16_t* hrow = (const bf16_t*)(p.ws + WS_H1) + ((size_t)which * 4096 + pm * 256 + 32 * wid + r32) * 256 + 8 * hi;
    const bf16_t* wrow = (const bf16_t*)(p.ws + WS_W2T) + ((size_t)which * 64 + r32) * 256 + 8 * hi;
    f32x16 a0, a1;
#pragma unroll
    for (int r = 0; r < 16; ++r) { a0[r] = 0.f; a1[r] = 0.f; }
#pragma unroll
    for (int ks = 0; ks < 16; ++ks) {
        const bf16x8 hf = *(const bf16x8*)(hrow + 16 * ks), w0 = *(const bf16x8*)(wrow + 16 * ks), w1 = *(const bf16x8*)(wrow + 32 * 256 + 16 * ks);
        a0 = __builtin_amdgcn_mfma_f32_32x32x16_bf16(hf, w0, a0, 0, 0, 0);
        a1 = __builtin_amdgcn_mfma_f32_32x32x16_bf16(hf, w1, a1, 0, 0, 0);
    }
    bf16_t* outb = (bf16_t*)(p.ws + (which ? WS_VC : WS_KC));
#pragma unroll
    for (int r = 0; r < 16; ++r) {
        const int rr = pm * 256 + 32 * wid + (r & 3) + 8 * (r >> 2) + 4 * hi;
        if (rr < NB * NCMP * 4) {
            const int b = rr / (NCMP * 4), rem = rr % (NCMP * 4), n = rem >> 2, h = rem & 3;
            bf16_t* op = outb + ((size_t)(b * 4 + h) * 512 + n) * 64 + r32;
            op[0] = f2bf(a0[r]); op[32] = f2bf(a1[r]);
            if (n == NCMP - 1) { op[64] = 0; op[96] = 0; }
        }
    }
}

__device__ __forceinline__ const float* bt_src_col(const Params& p, int n, int& ld) {
    ld = DIN;
    if (n < 512) return p.w_in + C_GQ + n;
    if (n < 1024) return p.w_in + C_GK + (n - 512);
    if (n < 2048) return p.w_in + C_GV + (n - 1024);
    if (n < 3072) return p.w_in + C_NQ + (n - 2048);
    if (n < 4608) return p.w_in + C_NKV + (n - 3072);
    if (n < 5632) return p.w_in + C_MQ + (n - 4608);
    if (n < 5648) return p.w_in + C_LR + (n - 5632);
    if (n < 5696) return p.w_in + C_NG + (n - 5648);
    if (n < 5888) return nullptr;
    if (n < 7936) { ld = 2048; return p.w_mem_kv + (n - 5888); }
    if (n < 8960) return p.w_in + C_GG + (n - 7936);
    if (n < 9984) return p.w_in + C_NGATE + (n - 8960);
    if (n < 11008) return p.w_in + C_MGATE + (n - 9984);
    if (n < 14080) return p.w_in + C_MERGE + (n - 11008);
    ld = 1024;
    if (n < 17152) { const int e = n - 14080; return p.w_branch + (size_t)(e >> 10) * 1024 * 1024 + (e & 1023); }
    return p.w_out + (n - 17152);
}
__device__ __forceinline__ void convert_item(const float* src0, int ld, bool gather, bool perm, const float* kgain, const Params& p, int nrow0, int k0, bf16_t* dst, int K, float* tile, int tid) {
    __syncthreads();
    if (!gather) {
        const int wid = tid >> 6, lane = tid & 63;
#pragma unroll
        for (int i = 0; i < 8; ++i) { const int kk = 8 * wid + i; const float4 v = *(const float4*)(src0 + (size_t)(k0 + kk) * ld + 4 * lane);
            const float gk = kgain ? kgain[(k0 + kk) & 255] : 1.f;
            float* tp = tile + kk * 257 + 4 * lane; tp[0] = v.x * gk; tp[1] = v.y * gk; tp[2] = v.z * gk; tp[3] = v.w * gk; }
    } else {
        for (int e = tid; e < 64 * 256; e += NTHREADS) { const int kk = e >> 8, n = e & 255; int l2; const float* cp = bt_src_col(p, nrow0 + n, l2); tile[kk * 257 + n] = cp ? cp[(size_t)(k0 + kk) * l2] : 0.f; }
    }
    __syncthreads();
#pragma unroll
    for (int u = 0; u < 4; ++u) { const int pid = tid + 512 * u, n = pid >> 3, kc = pid & 7;
        const int nl = perm ? (64 * ((n >> 5) & 3) + 32 * (n >> 7) + (n & 31)) : n;
        const float* s = tile + (8 * kc) * 257 + nl;
        u32x4 o; o.x = pg8::cvt_pk_bf16(s[0], s[257]); o.y = pg8::cvt_pk_bf16(s[2 * 257], s[3 * 257]); o.z = pg8::cvt_pk_bf16(s[4 * 257], s[5 * 257]); o.w = pg8::cvt_pk_bf16(s[6 * 257], s[7 * 257]);
        *(u32x4*)(dst + (size_t)n * K + k0 + 8 * kc) = o; }
}
__device__ __forceinline__ void phase_convert(const Params& p, float* sm, int bid, int nb) {
    const int tid = threadIdx.x;
    bf16_t* BT = (bf16_t*)(p.ws + WS_BT); bf16_t* BTC = (bf16_t*)(p.ws + WS_BTC);
    constexpr int NB256 = R_END / 256, N1 = 16 * NB256, N2 = 2 * 32;
    for (int it = bid; it < N1 + N2; it += nb) {
        if (it < N1) {
            const int kb = it / NB256, nbk = it % NB256, nrow0 = 256 * nbk; int ld; const float* cp = bt_src_col(p, nrow0, ld);
            const bool perm = (nrow0 >= 2048 && nrow0 < 3840) || nrow0 == 4096;
            convert_item(cp, ld, nrow0 == R_SMALL, perm, (nrow0 >= R_B && nrow0 < R_B + 1024) ? p.gla_out_norm : nullptr, p, nrow0, 64 * kb, BT + (size_t)nrow0 * 1024, 1024, sm, tid);
        } else {
            const int r = it - N1, which = r >> 5, kb = r & 31;
            convert_item(which ? p.wv1 : p.wk1, 256, false, false, nullptr, p, 0, 64 * kb, BTC + (size_t)which * 256 * 2048, 2048, sm, tid);
        }
    }
    bf16_t* W2T = (bf16_t*)(p.ws + WS_W2T);
    for (int idx = bid * NTHREADS + tid; idx < 2 * 64 * 256; idx += nb * NTHREADS) {
        const int f = idx & 255, d = (idx >> 8) & 63, which = idx >> 14;
        W2T[idx] = f2bf((which ? p.wv2 : p.wk2)[f * 64 + d]);
    }
}

__device__ __forceinline__ int queue_pop(unsigned* ctr, LAS unsigned char* lds) {
    LAS int* slot = (LAS int*)(lds + LDS_BYTES - 64);
    __syncthreads();
    if (threadIdx.x == 0) *slot = (int)atomicAdd(ctr, 1u);
    __syncthreads();
    return *slot;
}
__device__ __forceinline__ void phase_prep(const Params& p, int bid, int nb) {
    const int tid = threadIdx.x, lane = tid & 63, wave = tid >> 6;
    const int gw = bid * NWAVES + wave, NGW = nb * NWAVES;
    bf16_t* XN = (bf16_t*)p.out;
    for (int r = gw; r < M; r += NGW) {
        const float4* xr = (const float4*)(p.x + (size_t)r * DM);
        float4 v[4]; float ss = 0.f;
#pragma unroll
        for (int j = 0; j < 4; ++j) { v[j] = xr[lane + 64 * j]; ss += v[j].x * v[j].x + v[j].y * v[j].y + v[j].z * v[j].z + v[j].w * v[j].w; }
        ss = wave_sum(ss);
        const float rs = rsqrtf(ss * (1.f / DM) + EPS);
#pragma unroll
        for (int j = 0; j < 4; ++j) {
            const float4 g = ((const float4*)p.norm_gain)[lane + 64 * j];
            u32x2 w; w.x = pg8::cvt_pk_bf16(v[j].x * rs * g.x, v[j].y * rs * g.y); w.y = pg8::cvt_pk_bf16(v[j].z * rs * g.z, v[j].w * rs * g.w);
            *(u32x2*)(XN + (size_t)r * DM + (lane + 64 * j) * 4) = w;
        }
    }
    for (int r = gw; r < NB * NMEM; r += NGW) {
        const float4* xr = (const float4*)(p.mem + (size_t)r * DM);
        float4 v[4]; float ss = 0.f;
#pragma unroll
        for (int j = 0; j < 4; ++j) { v[j] = xr[lane + 64 * j]; ss += v[j].x * v[j].x + v[j].y * v[j].y + v[j].z * v[j].z + v[j].w * v[j].w; }
        ss = wave_sum(ss);
        const float rs = rsqrtf(ss * (1.f / DM) + EPS);
#pragma unroll
        for (int j = 0; j < 4; ++j) {
            const float4 g = ((const float4*)p.mem_norm_gain)[lane + 64 * j];
            u32x2 w; w.x = pg8::cvt_pk_bf16(v[j].x * rs * g.x, v[j].y * rs * g.y); w.y = pg8::cvt_pk_bf16(v[j].z * rs * g.z, v[j].w * rs * g.w);
            *(u32x2*)(XN + (size_t)(M + r) * DM + (lane + 64 * j) * 4) = w;
        }
    }
    float* COS = (float*)(p.ws + WS_COS); float* SIN = (float*)(p.ws + WS_SIN);
    for (int idx = bid * NTHREADS + tid; idx < M * 32; idx += nb * NTHREADS) {
        const int t = idx >> 5, i = idx & 31;
        const float inv = powf(10000.0f, -(float)i / 32.0f);
        const float ang = (float)p.pos[t] * inv;
        const double ad = (double)ang, kk = rint(ad * 0.15915494309189535);
        const float red = (float)(ad - kk * 6.283185307179586);
        COS[idx] = cosf(red); SIN[idx] = sinf(red);
    }
}

constexpr size_t WS_DEC = WS_MEMN;
__device__ __forceinline__ void phase_gla_prepass(const Params& p, float* sm, unsigned* ctr) {
    const int tid = threadIdx.x, k = tid & 127, qtr = tid >> 7;
    bf16_t* GQK = (bf16_t*)(p.ws + WS_GQK); const float* SM = (const float*)(p.ws + WS_SM); float* DEC = (float*)(p.ws + WS_DEC);
    float* gl = sm;
    float* tot = sm + 64 * 128;
    for (;;) {
        const int it = queue_pop(ctr, (LAS unsigned char*)sm);
        if (it >= 1024) break;
        const int h = it & 3, bc = it >> 2, b = bc >> 7, c = bc & 127;
        const size_t tc = (size_t)b * SEQ + c * 64;
        float w[16];
#pragma unroll
        for (int r = 0; r < 16; ++r) w[r] = p.w_alpha[r * 512 + h * 128 + k];
        const float bias = p.b_alpha[h * 128 + k];
        float gcum[16]; float run = 0.f;
#pragma unroll
        for (int i = 0; i < 16; ++i) {
            const float4* lr = (const float4*)(SM + (tc + 16 * qtr + i) * 64);
            const float4 l0 = lr[0], l1 = lr[1], l2 = lr[2], l3 = lr[3];
            float z = bias + l0.x * w[0] + l0.y * w[1] + l0.z * w[2] + l0.w * w[3] + l1.x * w[4] + l1.y * w[5] + l1.z * w[6] + l1.w * w[7]
                    + l2.x * w[8] + l2.y * w[9] + l2.z * w[10] + l2.w * w[11] + l3.x * w[12] + l3.y * w[13] + l3.z * w[14] + l3.w * w[15];
            const float ez = __builtin_amdgcn_exp2f(-1.4426950408889634f * fabsf(z));
            const float ls = fminf(z, 0.f) - 0.6931471805599453f * __builtin_amdgcn_logf(1.f + ez);
            run += ls * (1.f / 16.f); gcum[i] = run;
        }
        __syncthreads();
        tot[qtr * 128 + k] = run;
        __syncthreads();
        const float s0 = tot[k], s1 = tot[128 + k], s2 = tot[256 + k], s3 = tot[384 + k];
        const float off = (qtr > 0 ? s0 : 0.f) + (qtr > 1 ? s1 : 0.f) + (qtr > 2 ? s2 : 0.f);
#pragma unroll
        for (int i = 0; i < 16; ++i) gl[(16 * qtr + i) * 128 + k] = gcum[i] + off;
        if (qtr == 0) { const float gref = s0 + s1, glast = gref + s2 + s3; float* d = DEC + (size_t)it * 384; d[k] = expf(gref); d[128 + k] = expf(glast); d[256 + k] = expf(glast - gref); }
        __syncthreads();
        {
            const int tok = tid >> 3, k0 = (tid & 7) * 16;
            bf16_t* qp = GQK + (tc + tok) * 1024 + h * 128 + k0;
#pragma unroll
            for (int hf = 0; hf < 2; ++hf) {
                const u32x4 wq = *(const u32x4*)(qp + 8 * hf), wk = *(const u32x4*)(qp + 512 + 8 * hf);
                const float qv[8] = {bflo(wq.x), bfhi(wq.x), bflo(wq.y), bfhi(wq.y), bflo(wq.z), bfhi(wq.z), bflo(wq.w), bfhi(wq.w)};
                const float kv[8] = {bflo(wk.x), bfhi(wk.x), bflo(wk.y), bfhi(wk.y), bflo(wk.z), bfhi(wk.z), bflo(wk.w), bfhi(wk.w)};
                float eq[8], ek[8];
#pragma unroll
                for (int e = 0; e < 8; ++e) { const int kk = k0 + 8 * hf + e; const float d = gl[tok * 128 + kk] - gl[31 * 128 + kk];
                    const float ex = __builtin_amdgcn_exp2f(1.4426950408889634f * d); eq[e] = qv[e] * ex; ek[e] = kv[e] * __builtin_amdgcn_rcpf(ex); }
                u32x4 oq, ok;
                oq.x = pg8::cvt_pk_bf16(eq[0], eq[1]); oq.y = pg8::cvt_pk_bf16(eq[2], eq[3]); oq.z = pg8::cvt_pk_bf16(eq[4], eq[5]); oq.w = pg8::cvt_pk_bf16(eq[6], eq[7]);
                ok.x = pg8::cvt_pk_bf16(ek[0], ek[1]); ok.y = pg8::cvt_pk_bf16(ek[2], ek[3]); ok.z = pg8::cvt_pk_bf16(ek[4], ek[5]); ok.w = pg8::cvt_pk_bf16(ek[6], ek[7]);
                *(u32x4*)(qp + 8 * hf) = oq; *(u32x4*)(qp + 512 + 8 * hf) = ok;
            }
        }
    }
}
namespace gla2 {
typedef short bf16x8 __attribute__((ext_vector_type(8)));
typedef short s16x4 __attribute__((ext_vector_type(4)));
typedef short v4i16_t __attribute__((ext_vector_type(4)));
typedef float f32x16 __attribute__((ext_vector_type(16)));
typedef LAS const unsigned char* lptr;
constexpr int CH = 1088;
constexpr int G_Q = 0, G_K = 16 * CH, G_V = 32 * CH, G_A = 40 * CH, G_S = 48 * CH, G_D = 64 * CH, G_O = G_D + 2048, OPITCH = 144;
__device__ __forceinline__ int img(int row, int col) { return (col >> 3) * CH + row * 16 + (col & 7) * 2; }
__device__ __forceinline__ int crow(int r, int hi) { return (r & 3) + 8 * (r >> 2) + 4 * hi; }
__device__ __forceinline__ s16x4 vtr(lptr p) { return __builtin_bit_cast(s16x4, __builtin_amdgcn_ds_read_tr16_b64_v4i16((LAS v4i16_t*)p)); }
__device__ __forceinline__ bf16x8 afrag(lptr base, int tile, int ks, int r32, int hi) { return *(LAS const bf16x8*)(base + (2 * ks + hi) * CH + (32 * tile + r32) * 16); }
__device__ __forceinline__ bf16x8 trfrag(lptr base, int ctile, int s, int lane) {
    const int g = lane >> 4, hi = lane >> 5, q = (lane & 15) >> 2, pp = lane & 3;
    lptr a = base + img(16 * s + 8 * hi + q, 32 * ctile + 16 * (g & 1) + 4 * pp);
    const s16x4 lo = vtr(a), hh = vtr(a + 64);
    return (bf16x8){lo[0], lo[1], lo[2], lo[3], hh[0], hh[1], hh[2], hh[3]};
}
}
__device__ __forceinline__ void gla_main(const Params& p, LAS unsigned char* lds, int item) {
    using namespace gla2;
    int tid_ = threadIdx.x; asm volatile("" : "+v"(tid_));
    const int tid = tid_, lane = tid & 63, wid = __builtin_amdgcn_readfirstlane(tid >> 6), r32 = lane & 31, hi = lane >> 5;
    const int dvq = item & 3, h = (item >> 2) & 3, b = item >> 4;
    const bf16_t* GQK = (const bf16_t*)(p.ws + WS_GQK); bf16_t* GV = (bf16_t*)(p.ws + WS_GV); const float* DEC = (const float*)(p.ws + WS_DEC);
    const lptr L = (lptr)lds;
    const int qrow0 = tid >> 4, qch = tid & 15, vrow = tid >> 3, vch = tid & 7;
    const bf16_t* qsrc = GQK + ((size_t)b * SEQ + qrow0) * 1024 + h * 128 + qch * 8;
    const bf16_t* vsrc = GV + ((size_t)b * SEQ + vrow) * 1024 + h * 256 + dvq * 64 + vch * 8;
    const float* dsrc = DEC + (size_t)(b * 128 * 4 + h) * 384 + (tid < 96 ? tid * 4 : 0);
    u32x4 rq0, rq1, rk0, rk1, rv; f32x4 rd;
#define GLA_LOAD(c) do { const size_t o_ = (size_t)(c) * 64 * 1024; rq0 = *(const u32x4*)(qsrc + o_); rq1 = *(const u32x4*)(qsrc + o_ + 32 * 1024); rk0 = *(const u32x4*)(qsrc + o_ + 512); rk1 = *(const u32x4*)(qsrc + o_ + 32 * 1024 + 512); \
        rv = *(const u32x4*)(vsrc + o_); rd = *(const f32x4*)(dsrc + (size_t)(c) * 4 * 384); } while (0)
#define GLA_BAR() do { asm volatile("s_waitcnt lgkmcnt(0)" ::: "memory"); __builtin_amdgcn_s_barrier(); asm volatile("" ::: "memory"); } while (0)
    f32x16 S;
#pragma unroll
    for (int r = 0; r < 16; ++r) S[r] = 0.f;
    const int kb = wid >> 1, vb = wid & 1;
    GLA_LOAD(0);
    { u32x4 z = {0u, 0u, 0u, 0u}; *(u32x4*)(p.ws + 262144 + (size_t)item * 8192 + tid * 16) = z; }
    for (int c = 0; c < SEQ / 64; ++c) {
        *(LAS u32x4*)(lds + G_Q + qch * CH + qrow0 * 16) = rq0; *(LAS u32x4*)(lds + G_Q + qch * CH + (qrow0 + 32) * 16) = rq1;
        *(LAS u32x4*)(lds + G_K + qch * CH + qrow0 * 16) = rk0; *(LAS u32x4*)(lds + G_K + qch * CH + (qrow0 + 32) * 16) = rk1;
        *(LAS u32x4*)(lds + G_V + vch * CH + vrow * 16) = rv;
        if (tid < 96) *(LAS f32x4*)(lds + G_D + tid * 16) = rd;
        GLA_BAR();
        GLA_LOAD(c + 1 < SEQ / 64 ? c + 1 : c);
#pragma unroll
        for (int a = 0; a < 4; ++a) {
            const int dk0 = 32 * kb + 8 * a + 4 * hi;
            const f32x4 er = *(LAS const f32x4*)(lds + G_D + dk0 * 4);
            u32x2 w; w.x = pg8::cvt_pk_bf16(S[4 * a] * er[0], S[4 * a + 1] * er[1]); w.y = pg8::cvt_pk_bf16(S[4 * a + 2] * er[2], S[4 * a + 3] * er[3]);
            *(LAS u32x2*)(lds + G_S + img(32 * vb + r32, dk0)) = w;
        }
        if (wid < 3) {
            const int tj = (wid == 2) ? 1 : 0, ti = (wid == 0) ? 0 : 1;
            f32x16 at;
#pragma unroll
            for (int r = 0; r < 16; ++r) at[r] = 0.f;
#pragma unroll
            for (int ks = 0; ks < 8; ++ks) at = __builtin_amdgcn_mfma_f32_32x32x16_bf16(afrag(L + G_K, tj, ks, r32, hi), afrag(L + G_Q, ti, ks, r32, hi), at, 0, 0, 0);
            const int lim = (ti == tj) ? (r32 - 4 * hi) : 64;
#pragma unroll
            for (int a = 0; a < 4; ++a) {
                const float v0 = (crow(4 * a, 0) <= lim) ? at[4 * a] : 0.f, v1 = (crow(4 * a + 1, 0) <= lim) ? at[4 * a + 1] : 0.f;
                const float v2 = (crow(4 * a + 2, 0) <= lim) ? at[4 * a + 2] : 0.f, v3 = (crow(4 * a + 3, 0) <= lim) ? at[4 * a + 3] : 0.f;
                u32x2 w; w.x = pg8::cvt_pk_bf16(v0, v1); w.y = pg8::cvt_pk_bf16(v2, v3);
                *(LAS u32x2*)(lds + G_A + img(32 * ti + r32, 32 * tj + 8 * a + 4 * hi)) = w;
            }
        }
        GLA_BAR();
        if (wid < 4) {
            const int ti = wid >> 1, vj = wid & 1;
            f32x16 o;
#pragma unroll
            for (int r = 0; r < 16; ++r) o[r] = 0.f;
#pragma unroll
            for (int ks = 0; ks < 8; ++ks) o = __builtin_amdgcn_mfma_f32_32x32x16_bf16(afrag(L + G_S, vj, ks, r32, hi), afrag(L + G_Q, ti, ks, r32, hi), o, 0, 0, 0);
            for (int s = 0; s < 2 * ti + 2; ++s) o = __builtin_amdgcn_mfma_f32_32x32x16_bf16(trfrag(L + G_V, vj, s, lane), afrag(L + G_A, ti, s, r32, hi), o, 0, 0, 0);
#pragma unroll
            for (int a = 0; a < 4; ++a) { u32x2 w; w.x = pg8::cvt_pk_bf16(o[4 * a], o[4 * a + 1]); w.y = pg8::cvt_pk_bf16(o[4 * a + 2], o[4 * a + 3]);
                *(LAS u32x2*)(lds + G_O + (32 * ti + r32) * OPITCH + (32 * vj + 8 * a + 4 * hi) * 2) = w; }
        }
        {
            f32x16 T;
#pragma unroll
            for (int r = 0; r < 16; ++r) T[r] = 0.f;
#pragma unroll
            for (int s = 0; s < 4; ++s) T = __builtin_amdgcn_mfma_f32_32x32x16_bf16(trfrag(L + G_K, kb, s, lane), trfrag(L + G_V, vb, s, lane), T, 0, 0, 0);
#pragma unroll
            for (int a = 0; a < 4; ++a) {
                const int dk0 = 32 * kb + 8 * a + 4 * hi;
                const f32x4 d1 = *(LAS const f32x4*)(lds + G_D + 512 + dk0 * 4), d2 = *(LAS const f32x4*)(lds + G_D + 1024 + dk0 * 4);
                S[4 * a] = d1[0] * S[4 * a] + d2[0] * T[4 * a]; S[4 * a + 1] = d1[1] * S[4 * a + 1] + d2[1] * T[4 * a + 1];
                S[4 * a + 2] = d1[2] * S[4 * a + 2] + d2[2] * T[4 * a + 2]; S[4 * a + 3] = d1[3] * S[4 * a + 3] + d2[3] * T[4 * a + 3];
            }
        }
        GLA_BAR();
        { const u32x4 w = *(LAS const u32x4*)(lds + G_O + vrow * OPITCH + vch * 16); *(u32x4*)(const_cast<bf16_t*>(vsrc) + (size_t)c * 64 * 1024) = w; }
    }
#undef GLA_LOAD
#undef GLA_BAR
    __syncthreads();
    {
        float* RSSQ = (float*)(p.ws + WS_RSTD);
        const int sub = lane >> 3, c8 = lane & 7;
        for (int r0 = wid * 8; r0 < SEQ; r0 += NWAVES * 8) {
            const int tr = r0 + sub;
            const u32x4 w = *(const u32x4*)(GV + ((size_t)b * SEQ + tr) * 1024 + h * 256 + dvq * 64 + 8 * c8);
            float ss = bflo(w.x) * bflo(w.x) + bfhi(w.x) * bfhi(w.x) + bflo(w.y) * bflo(w.y) + bfhi(w.y) * bfhi(w.y) + bflo(w.z) * bflo(w.z) + bfhi(w.z) * bfhi(w.z) + bflo(w.w) * bflo(w.w) + bfhi(w.w) * bfhi(w.w);
            ss += __shfl_xor(ss, 1); ss += __shfl_xor(ss, 2); ss += __shfl_xor(ss, 4);
            if (c8 == 0) RSSQ[((size_t)b * SEQ + tr) * 16 + h * 4 + dvq] = ss;
        }
    }
}

__device__ __forceinline__ void phase_memattn_mfma(const Params& p, int bid, int nb) {
    typedef short bf16x8 __attribute__((ext_vector_type(8)));
    typedef float f32x16 __attribute__((ext_vector_type(16)));
    int tid_ = threadIdx.x; asm volatile("" : "+v"(tid_));
    const int tid = tid_, lane = tid & 63, wave = tid >> 6, r32 = lane & 31, hi = lane >> 5;
    const int gw = bid * NWAVES + wave, NGW = nb * NWAVES;
    bf16_t* MQ = (bf16_t*)(p.ws + WS_MQ); const bf16_t* MKB = (const bf16_t*)(p.ws + WS_MKB); const bf16_t* MVT = (const bf16_t*)(p.ws + WS_MVT);
    constexpr float C2M = 1.0f;
    for (int it = gw; it < (M / 32) * 4; it += NGW) {
        const int h = it & 3, tb = it >> 2, b = tb / (SEQ / 32);
        const int qoff = (tb * 32 + r32) * 1024 + h * 256;
        const bf16_t* kb = MKB + (size_t)(b * 4 + h) * 65536; const bf16_t* vt = MVT + (size_t)(b * 4 + h) * 65536;
        f32x16 s[8];
#pragma unroll
        for (int kt = 0; kt < 8; ++kt) {
            asm volatile("" ::: "memory");
#pragma unroll
            for (int r = 0; r < 16; ++r) s[kt][r] = 0.f;
#pragma unroll
            for (int ks = 0; ks < 16; ++ks) { const bf16x8 qf = *(const bf16x8*)(MQ + qoff + 16 * ks + 8 * hi);
                const bf16x8 kf = *(const bf16x8*)(kb + (32 * kt + r32) * 256 + 16 * ks + 8 * hi); s[kt] = __builtin_amdgcn_mfma_f32_32x32x16_bf16(kf, qf, s[kt], 0, 0, 0); }
        }
        asm volatile("" ::: "memory");
        float mx = -INFINITY;
#pragma unroll
        for (int kt = 0; kt < 8; ++kt)
#pragma unroll
            for (int r = 0; r < 16; ++r) mx = fmaxf(mx, s[kt][r]);
        mx = fmaxf(mx, __shfl_xor(mx, 32)) * C2M;
        float l = 0.f;
#pragma unroll
        for (int kt = 0; kt < 8; ++kt)
#pragma unroll
            for (int r = 0; r < 16; ++r) { s[kt][r] = __builtin_amdgcn_exp2f(s[kt][r] * C2M - mx); l += s[kt][r]; }
        l += __shfl_xor(l, 32);
        const float linv = 1.f / l;
        u32x4 pw[16];
#pragma unroll
        for (int st = 0; st < 16; ++st) { const int kt = st >> 1, r0 = 8 * (st & 1);
            pw[st].x = pg8::cvt_pk_bf16(s[kt][r0] * linv, s[kt][r0 + 1] * linv); pw[st].y = pg8::cvt_pk_bf16(s[kt][r0 + 2] * linv, s[kt][r0 + 3] * linv);
            pw[st].z = pg8::cvt_pk_bf16(s[kt][r0 + 4] * linv, s[kt][r0 + 5] * linv); pw[st].w = pg8::cvt_pk_bf16(s[kt][r0 + 6] * linv, s[kt][r0 + 7] * linv); }
#pragma unroll 1
        for (int dt = 0; dt < 8; ++dt) {
            f32x16 o;
#pragma unroll
            for (int r = 0; r < 16; ++r) o[r] = 0.f;
            const bf16_t* vrow = vt + (32 * dt + r32) * 256 + 4 * hi;
#pragma unroll
            for (int st = 0; st < 16; ++st) {
                const u32x2 lo = *(const u32x2*)(vrow + 16 * st), hh = *(const u32x2*)(vrow + 16 * st + 8);
                const u32x4 vf = {lo.x, lo.y, hh.x, hh.y};
                o = __builtin_amdgcn_mfma_f32_32x32x16_bf16(__builtin_bit_cast(bf16x8, vf), __builtin_bit_cast(bf16x8, pw[st]), o, 0, 0, 0);
            }
#pragma unroll
            for (int a = 0; a < 4; ++a) { u32x2 w; w.x = pg8::cvt_pk_bf16(o[4 * a], o[4 * a + 1]); w.y = pg8::cvt_pk_bf16(o[4 * a + 2], o[4 * a + 3]);
                *(u32x2*)(MQ + qoff + 32 * dt + 8 * a + 4 * hi) = w; }
        }
    }
}
__device__ __forceinline__ void phase_memattn_lds(const Params& p, LAS unsigned char* lds, unsigned* ctr) {
    typedef short bf16x8 __attribute__((ext_vector_type(8)));
    typedef float f32x16 __attribute__((ext_vector_type(16)));
    int tid_ = threadIdx.x; asm volatile("" : "+v"(tid_));
    const int tid = tid_, lane = tid & 63, wid = __builtin_amdgcn_readfirstlane(tid >> 6), r32 = lane & 31, hi = lane >> 5;
    float gq = 0.f, gk = 0.f;
#pragma unroll
    for (int j = 0; j < 4; ++j) { gq = fmaxf(gq, fabsf(p.mem_q_norm[lane + 64 * j])); gk = fmaxf(gk, fabsf(p.mem_k_norm[lane + 64 * j])); }
    gq = wave_max(gq); gk = wave_max(gk);
    const float B = 23.0831207f * 1.02f * gq * gk;
    if (__builtin_amdgcn_readfirstlane((int)(B < 60.f)) == 0) {
        if (queue_pop(ctr, lds) < (int)gridDim.x) phase_memattn_mfma(p, blockIdx.x, gridDim.x); return; }
    bf16_t* MQ = (bf16_t*)(p.ws + WS_MQ); const bf16_t* MKB = (const bf16_t*)(p.ws + WS_MKB); const bf16_t* MVT = (const bf16_t*)(p.ws + WS_MVT);
    constexpr int KCH = 1040, VROW = 272, BUF = 36864, OSTP = 272;
#define MEM_LDK(tile) do { _Pragma("unroll") for (int u = 0; u < 4; ++u) { const int pid = tid + 512 * u; st[u] = *(const u32x4*)(kb + (64 * (tile) + (pid >> 5)) * 256 + (pid & 31) * 8); } } while (0)
#define MEM_STK(buf) do { _Pragma("unroll") for (int u = 0; u < 4; ++u) { const int pid = tid + 512 * u; *(LAS u32x4*)(lds + (buf) * BUF + (pid & 31) * KCH + (pid >> 5) * 16) = st[u]; } } while (0)
#define MEM_LDV(ph, kt) do { _Pragma("unroll") for (int u = 0; u < 4; ++u) { const int pid = tid + 512 * u; st[u] = *(const u32x4*)(vt + (128 * (ph) + (pid >> 4)) * 256 + 128 * (kt) + (pid & 15) * 8); } } while (0)
#define MEM_STV(buf) do { _Pragma("unroll") for (int u = 0; u < 4; ++u) { const int pid = tid + 512 * u; *(LAS u32x4*)(lds + (buf) * BUF + (pid >> 4) * VROW + (pid & 15) * 16) = st[u]; } } while (0)
    for (;;) {
        const int item = queue_pop(ctr, lds);
        if (item >= 256) break;
        int tidi = tid_; asm volatile("" : "+v"(tidi));
        const int tid = tidi, lane = tid & 63, r32 = lane & 31, hi = lane >> 5;
        const int bh = item >> 5, tb = item & 31, b = bh >> 2, h = bh & 3;
        const int qoff = (b * SEQ + tb * 256 + 32 * wid + r32) * 1024 + h * 256;
        const bf16_t* kb = MKB + (size_t)bh * 65536; const bf16_t* vt = MVT + (size_t)bh * 65536;
        u32x4 st[4];
        MEM_LDK(0);
        bf16x8 qf[16];
#pragma unroll
        for (int ks = 0; ks < 16; ++ks) qf[ks] = *(const bf16x8*)(MQ + qoff + 16 * ks + 8 * hi);
        MEM_STK(0); MEM_LDK(1);
        __syncthreads();
        u32x4 pw[16]; float l = 0.f;
#pragma unroll
        for (int t = 0; t < 4; ++t) {
            const LAS unsigned char* kbuf = lds + (t & 1) * BUF;
#pragma unroll
            for (int kh = 0; kh < 2; ++kh) {
                f32x16 pp;
#pragma unroll
                for (int r = 0; r < 16; ++r) pp[r] = -B;
#pragma unroll
                for (int kq = 0; kq < 2; ++kq) {
                    bf16x8 kf[8];
#pragma unroll
                    for (int i = 0; i < 8; ++i) kf[i] = *(LAS const bf16x8*)(kbuf + (2 * (8 * kq + i) + hi) * KCH + r32 * 16 + 512 * kh);
#pragma unroll
                    for (int i = 0; i < 8; ++i) pp = __builtin_amdgcn_mfma_f32_32x32x16_bf16(kf[i], qf[8 * kq + i], pp, 0, 0, 0);
                    __builtin_amdgcn_sched_group_barrier(0x100, 8, 5); __builtin_amdgcn_sched_group_barrier(0x008, 8, 5);
                }
#pragma unroll
                for (int r = 0; r < 16; ++r) { pp[r] = __builtin_amdgcn_exp2f(pp[r]); l += pp[r]; }
                u32x4 wa, wb;
                wa.x = pg8::cvt_pk_bf16(pp[0], pp[1]); wa.y = pg8::cvt_pk_bf16(pp[2], pp[3]); wa.z = pg8::cvt_pk_bf16(pp[4], pp[5]); wa.w = pg8::cvt_pk_bf16(pp[6], pp[7]);
                wb.x = pg8::cvt_pk_bf16(pp[8], pp[9]); wb.y = pg8::cvt_pk_bf16(pp[10], pp[11]); wb.z = pg8::cvt_pk_bf16(pp[12], pp[13]); wb.w = pg8::cvt_pk_bf16(pp[14], pp[15]);
                pw[4 * t + 2 * kh] = wa; pw[4 * t + 2 * kh + 1] = wb;
            }
            if (t < 3) { MEM_STK((t + 1) & 1); if (t < 2) MEM_LDK(t + 2); else MEM_LDV(0, 0); }
            else { MEM_STV(0); MEM_LDV(0, 1); }
            __syncthreads();
        }
        const float lt = l + __shfl_xor(l, 32), linv = 1.f / lt;
#pragma unroll
        for (int ph = 0; ph < 2; ++ph) {
            f32x16 o[4];
#pragma unroll
            for (int dt = 0; dt < 4; ++dt)
#pragma unroll
                for (int r = 0; r < 16; ++r) o[dt][r] = 0.f;
#pragma unroll
            for (int kt = 0; kt < 2; ++kt) {
                const LAS unsigned char* vbuf = lds + kt * BUF;
#pragma unroll
                for (int dt = 0; dt < 4; ++dt) {
                    const LAS unsigned char* vr = vbuf + (32 * dt + r32) * VROW + 8 * hi;
                    u32x2 lo[8], hh[8];
#pragma unroll
                    for (int s = 0; s < 8; ++s) { lo[s] = *(LAS const u32x2*)(vr + 32 * s); hh[s] = *(LAS const u32x2*)(vr + 32 * s + 16); }
#pragma unroll
                    for (int s = 0; s < 8; ++s) {
                        const u32x4 vf = {lo[s][0], lo[s][1], hh[s][0], hh[s][1]};
                        o[dt] = __builtin_amdgcn_mfma_f32_32x32x16_bf16(__builtin_bit_cast(bf16x8, vf), __builtin_bit_cast(bf16x8, pw[8 * kt + s]), o[dt], 0, 0, 0);
                    }
                    __builtin_amdgcn_sched_group_barrier(0x100, 16, 6); __builtin_amdgcn_sched_group_barrier(0x008, 8, 6);
                }
                const int nx = 2 * ph + kt + 1;
                if (nx < 4) { MEM_STV(nx & 1); if (nx < 3) MEM_LDV((nx + 1) >> 1, (nx + 1) & 1); __syncthreads(); }
            }
            {
                LAS unsigned char* ost = lds + 2 * BUF + (32 * wid) * OSTP;
#pragma unroll
                for (int dt = 0; dt < 4; ++dt)
#pragma unroll
                    for (int a = 0; a < 4; ++a) { u32x2 w; w.x = pg8::cvt_pk_bf16(o[dt][4 * a] * linv, o[dt][4 * a + 1] * linv); w.y = pg8::cvt_pk_bf16(o[dt][4 * a + 2] * linv, o[dt][4 * a + 3] * linv);
                        *(LAS u32x2*)(ost + r32 * OSTP + (32 * dt + 8 * a + 4 * hi) * 2) = w; }
                asm volatile("s_waitcnt lgkmcnt(0)" ::: "memory");
                bf16_t* orow = MQ + (size_t)(b * SEQ + tb * 256 + 32 * wid) * 1024 + h * 256 + 128 * ph;
#pragma unroll
                for (int i = 0; i < 8; ++i) { const int pc = lane + 64 * i, row = pc >> 4, c16 = pc & 15;
                    const u32x4 w = *(LAS const u32x4*)(ost + row * OSTP + c16 * 16);
                    *(u32x4*)(orow + (size_t)row * 1024 + c16 * 8) = w; }
                asm volatile("s_waitcnt lgkmcnt(0)" ::: "memory");
            }
        }
    }
#undef MEM_LDK
#undef MEM_STK
#undef MEM_LDV
#undef MEM_STV
}
namespace nsa2 {
typedef short bf16x8 __attribute__((ext_vector_type(8)));
typedef short s16x4 __attribute__((ext_vector_type(4)));
typedef short v4i16_t __attribute__((ext_vector_type(4)));
typedef float f32x16 __attribute__((ext_vector_type(16)));
typedef LAS const unsigned char* lptr;
constexpr int IP = 136;
constexpr int L_K = 0, L_V = 16384, L_IA = 32768, L_IB = L_IA + 64 * IP * 4, L_CTR = L_IB + 64 * IP * 4, L_Q = L_CTR + 256;
constexpr float C2 = 0.125f * 1.4426950408889634f;
__device__ __forceinline__ int crow(int r, int hi) { return (r & 3) + 8 * (r >> 2) + 4 * hi; }
__device__ __forceinline__ s16x4 vtr(lptr p) { return __builtin_bit_cast(s16x4, __builtin_amdgcn_ds_read_tr16_b64_v4i16((LAS v4i16_t*)p)); }
__device__ __forceinline__ int tile_koff(int pitch, int wid, int lane) { return lane * pitch + wid * 8; }
__device__ __forceinline__ int tile_voff(int pitch, int wid, int lane) { return (16 * (wid & 3) + (lane >> 2)) * pitch + (wid >> 2) * 32 + (lane & 3) * 8; }
__device__ __forceinline__ void tile_load(u32x4& kr, u32x4& vr, const bf16_t* kb, const bf16_t* vb, int koff, int voff) {
    kr = *(const u32x4*)(kb + koff);
    vr = *(const u32x4*)(vb + voff);
}
__device__ __forceinline__ void tile_store(LAS unsigned char* lds, int slot, const u32x4& kr, const u32x4& vr, int wid, int lane) {
    *(LAS u32x4*)(lds + L_K + slot * 8192 + wid * 1024 + lane * 16) = kr;
    *(LAS u32x4*)(lds + L_V + slot * 8192 + wid * 1024 + lane * 16) = vr;
}
__device__ __forceinline__ void qkt(f32x16& p0, f32x16& p1, lptr Kslot, lptr qr, int r32, int hi, float init = 0.f) {
    lptr kb = Kslot + hi * 1024 + r32 * 16;
#pragma unroll
    for (int r = 0; r < 16; ++r) { p0[r] = init; p1[r] = init; }
    bf16x8 b0[4], b1[4], qf[4];
#pragma unroll
    for (int d0 = 0; d0 < 4; ++d0) { b0[d0] = *(LAS const bf16x8*)(kb + d0 * 2048); b1[d0] = *(LAS const bf16x8*)(kb + d0 * 2048 + 512); qf[d0] = *(LAS const bf16x8*)(qr + d0 * 8192); }
#pragma unroll
    for (int d0 = 0; d0 < 4; ++d0) {
        p0 = __builtin_amdgcn_mfma_f32_32x32x16_bf16(b0[d0], qf[d0], p0, 0, 0, 0);
        p1 = __builtin_amdgcn_mfma_f32_32x32x16_bf16(b1[d0], qf[d0], p1, 0, 0, 0);
    }
    __builtin_amdgcn_sched_group_barrier(0x100, 9, 0);
    __builtin_amdgcn_sched_group_barrier(0x008, 2, 0);
    __builtin_amdgcn_sched_group_barrier(0x100, 3, 0);
    __builtin_amdgcn_sched_group_barrier(0x008, 6, 0);
}
__device__ __forceinline__ unsigned pk(float lo, float hi) { return pg8::cvt_pk_bf16(lo, hi); }
__device__ __forceinline__ int group8_sum(int v) {
    v += __builtin_amdgcn_mov_dpp(v, 0xB1, 0xF, 0xF, true);
    v += __builtin_amdgcn_mov_dpp(v, 0x4E, 0xF, 0xF, true);
    v += __builtin_amdgcn_mov_dpp(v, 0x141, 0xF, 0xF, true);
    return v;
}
__device__ __forceinline__ float quad_sum(float v) {
    v += __builtin_bit_cast(float, __builtin_amdgcn_mov_dpp(__builtin_bit_cast(int, v), 0xB1, 0xF, 0xF, true));
    v += __builtin_bit_cast(float, __builtin_amdgcn_mov_dpp(__builtin_bit_cast(int, v), 0x4E, 0xF, 0xF, true));
    return v;
}
__device__ __forceinline__ void pvt(f32x16 (&o)[2], lptr Vslot, const f32x16& p0, const f32x16& p1, int lane, int hi) {
    lptr vp = Vslot + ((lane >> 4) & 1) * 32 + (lane & 3) * 8 + (4 * hi + ((lane & 15) >> 2)) * 64;
    u32x4 w0, w1, w2, w3;
    w0.x = pk(p0[0], p0[1]); w0.y = pk(p0[2], p0[3]); w0.z = pk(p0[4], p0[5]); w0.w = pk(p0[6], p0[7]);
    w1.x = pk(p0[8], p0[9]); w1.y = pk(p0[10], p0[11]); w1.z = pk(p0[12], p0[13]); w1.w = pk(p0[14], p0[15]);
    w2.x = pk(p1[0], p1[1]); w2.y = pk(p1[2], p1[3]); w2.z = pk(p1[4], p1[5]); w2.w = pk(p1[6], p1[7]);
    w3.x = pk(p1[8], p1[9]); w3.y = pk(p1[10], p1[11]); w3.z = pk(p1[12], p1[13]); w3.w = pk(p1[14], p1[15]);
    const bf16x8 pw0 = __builtin_bit_cast(bf16x8, w0), pw1 = __builtin_bit_cast(bf16x8, w1), pw2 = __builtin_bit_cast(bf16x8, w2), pw3 = __builtin_bit_cast(bf16x8, w3);
    s16x4 lo[2][4], hh[2][4];
#pragma unroll
    for (int ks = 0; ks < 4; ++ks)
#pragma unroll
        for (int d0 = 0; d0 < 2; ++d0) { lo[d0][ks] = vtr(vp + d0 * 4096 + ks * 1024); hh[d0][ks] = vtr(vp + d0 * 4096 + ks * 1024 + 512); }
#define NSA_VF(d, k) (bf16x8){lo[d][k][0], lo[d][k][1], lo[d][k][2], lo[d][k][3], hh[d][k][0], hh[d][k][1], hh[d][k][2], hh[d][k][3]}
    o[0] = __builtin_amdgcn_mfma_f32_32x32x16_bf16(NSA_VF(0, 0), pw0, o[0], 0, 0, 0); o[1] = __builtin_amdgcn_mfma_f32_32x32x16_bf16(NSA_VF(1, 0), pw0, o[1], 0, 0, 0);
    o[0] = __builtin_amdgcn_mfma_f32_32x32x16_bf16(NSA_VF(0, 1), pw1, o[0], 0, 0, 0); o[1] = __builtin_amdgcn_mfma_f32_32x32x16_bf16(NSA_VF(1, 1), pw1, o[1], 0, 0, 0);
    o[0] = __builtin_amdgcn_mfma_f32_32x32x16_bf16(NSA_VF(0, 2), pw2, o[0], 0, 0, 0); o[1] = __builtin_amdgcn_mfma_f32_32x32x16_bf16(NSA_VF(1, 2), pw2, o[1], 0, 0, 0);
    o[0] = __builtin_amdgcn_mfma_f32_32x32x16_bf16(NSA_VF(0, 3), pw3, o[0], 0, 0, 0); o[1] = __builtin_amdgcn_mfma_f32_32x32x16_bf16(NSA_VF(1, 3), pw3, o[1], 0, 0, 0);
#undef NSA_VF
    __builtin_amdgcn_sched_group_barrier(0x100, 8, 1);
    __builtin_amdgcn_sched_group_barrier(0x008, 4, 1);
    __builtin_amdgcn_sched_group_barrier(0x100, 8, 1);
    __builtin_amdgcn_sched_group_barrier(0x008, 4, 1);
}
__device__ __forceinline__ float tile_max(const f32x16& p0, const f32x16& p1) {
    float a = fmaxf(p0[0], p1[0]);
#pragma unroll
    for (int r = 1; r < 16; ++r) a = fmaxf(a, fmaxf(p0[r], p1[r]));
    return fmaxf(a, __shfl_xor(a, 32));
}
__device__ __forceinline__ void osm_step(f32x16& p0, f32x16& p1, float& m, float& l, f32x16 (&o)[2], lptr Vslot, int lane, int hi) {
    const float mx = tile_max(p0, p1);
    const float mn = fmaxf(m, mx), mu = (mn == -INFINITY) ? 0.f : mn;
    const float alpha = __builtin_amdgcn_exp2f(m - mu);
    float ls = 0.f;
#pragma unroll
    for (int r = 0; r < 16; ++r) { p0[r] = __builtin_amdgcn_exp2f(p0[r] - mu); p1[r] = __builtin_amdgcn_exp2f(p1[r] - mu); ls += p0[r] + p1[r]; }
    l = l * alpha + ls; m = mn;
#pragma unroll
    for (int r = 0; r < 16; ++r) { o[0][r] *= alpha; o[1][r] *= alpha; }
    pvt(o, Vslot, p0, p1, lane, hi);
}
template <int MODE>
__device__ __forceinline__ void fast_first(u32x4& pk0, u32x4& pv0, u32x4& pk1, const bf16_t* kb, const bf16_t* vb, int kofs, int vofs, int blk) {
    const int jlo = (MODE == 1) ? max(0, blk - 8) : 0, nt = (MODE == 1) ? (blk - jlo + 1) : (blk + 1);
    const int j0 = (MODE == 1) ? blk : 0, j1 = (nt > 1) ? ((MODE == 1) ? jlo : 1) : j0;
    const __amdgpu_buffer_rsrc_t rk = __builtin_amdgcn_make_buffer_rsrc((void*)kb, (short)0, SEQ * 1536 * 2, 0x00020000), rv = __builtin_amdgcn_make_buffer_rsrc((void*)vb, (short)0, SEQ * 1536 * 2, 0x00020000);
    pk0 = __builtin_bit_cast(u32x4, __builtin_amdgcn_raw_buffer_load_b128(rk, (unsigned)kofs * 2u, (unsigned)j0 * (64u * 1536u * 2u), 0));
    pv0 = __builtin_bit_cast(u32x4, __builtin_amdgcn_raw_buffer_load_b128(rv, (unsigned)vofs * 2u, (unsigned)j0 * (64u * 1536u * 2u), 0));
    pk1 = __builtin_bit_cast(u32x4, __builtin_amdgcn_raw_buffer_load_b128(rk, (unsigned)kofs * 2u, (unsigned)j1 * (64u * 1536u * 2u), 0));
}
template <int MODE>
__device__ __forceinline__ void fast_loop(LAS unsigned char* lds, const bf16_t* kb, const bf16_t* vb, int kofs, int vofs, int blk, int tl, int t, unsigned long long mylo, unsigned long long myhi,
                                          float Bnd, lptr qr, f32x16 (&oacc)[2], float& l, int wid, int lane, int r32, int hi, u32x4 pk0, u32x4 pv0, u32x4 pk1) {
    const int jlo = (MODE == 1) ? max(0, blk - 8) : 0, nt = (MODE == 1) ? (blk - jlo + 1) : (blk + 1);
    auto tile_of = [&](int i) -> int { return (MODE == 1) ? ((i == 0) ? blk : jlo + i - 1) : i; };
    auto sel_of = [&](int j) -> bool { return (MODE == 1) ? true : ((j < 64) ? (((mylo >> j) & 1ull) != 0ull) : (((myhi >> (j - 64)) & 1ull) != 0ull)); };
    u32x4 krA, vrA, krB, vrB;
    const unsigned kofb = (unsigned)kofs * 2u, vofb = (unsigned)vofs * 2u;
    const __amdgpu_buffer_rsrc_t rk = __builtin_amdgcn_make_buffer_rsrc((void*)kb, (short)0, SEQ * 1536 * 2, 0x00020000), rv = __builtin_amdgcn_make_buffer_rsrc((void*)vb, (short)0, SEQ * 1536 * 2, 0x00020000);
    {
        const int j1 = tile_of(min(1, nt - 1)), j2 = tile_of(min(2, nt - 1));
        *(LAS u32x4*)(lds + L_K + wid * 1024 + lane * 16) = pk0; *(LAS u32x4*)(lds + L_V + wid * 1024 + lane * 16) = pv0;
        *(LAS u32x4*)(lds + L_K + 8192 + wid * 1024 + lane * 16) = pk1;
        krB = __builtin_bit_cast(u32x4, __builtin_amdgcn_raw_buffer_load_b128(rk, kofb, (unsigned)j2 * (64u * 1536u * 2u), 0));
        vrB = __builtin_bit_cast(u32x4, __builtin_amdgcn_raw_buffer_load_b128(rv, vofb, (unsigned)j1 * (64u * 1536u * 2u), 0));
    }
    __syncthreads();
    f32x16 sa0, sa1, sb0, sb1;
    {
        const bool s0 = sel_of(tile_of(0));
        if (__any(s0)) qkt(sa0, sa1, (lptr)lds + L_K, qr, r32, hi, s0 ? -Bnd : -INFINITY);
    }
    __syncthreads();
    auto step = [&](int i, f32x16& c0, f32x16& c1, f32x16& n0, f32x16& n1, u32x4& krL, u32x4& vrL, const u32x4& krS, const u32x4& vrS) {
        const int j = tile_of(i);
        krL = __builtin_bit_cast(u32x4, __builtin_amdgcn_raw_buffer_load_b128(rk, kofb, (unsigned)tile_of(min(i + 3, nt - 1)) * (64u * 1536u * 2u), 0));
        vrL = __builtin_bit_cast(u32x4, __builtin_amdgcn_raw_buffer_load_b128(rv, vofb, (unsigned)tile_of(min(i + 2, nt - 1)) * (64u * 1536u * 2u), 0));
        if (i + 1 < nt) { const bool sn = sel_of(tile_of(i + 1)); if (__any(sn)) qkt(n0, n1, (lptr)lds + L_K + ((i + 1) & 1) * 8192, qr, r32, hi, sn ? -Bnd : -INFINITY); }
        if (__any(sel_of(j))) {
            bool masked; int klo, khi;
            if (MODE == 0) { masked = (j == blk); klo = -64; khi = tl - 4 * hi; }
            else { masked = (j == blk) || (j == blk - 8); klo = t - 511 - 64 * j - 4 * hi; khi = t - 64 * j - 4 * hi; }
            if (masked) {
#pragma unroll
                for (int r = 0; r < 16; ++r) { const int kk = crow(r, 0); c0[r] = (kk >= klo && kk <= khi) ? __builtin_amdgcn_exp2f(c0[r]) : 0.f; c1[r] = (kk + 32 >= klo && kk + 32 <= khi) ? __builtin_amdgcn_exp2f(c1[r]) : 0.f; }
            } else {
#pragma unroll
                for (int r = 0; r < 16; ++r) { c0[r] = __builtin_amdgcn_exp2f(c0[r]); c1[r] = __builtin_amdgcn_exp2f(c1[r]); }
            }
            float ls = 0.f;
#pragma unroll
            for (int r = 0; r < 16; ++r) ls += c0[r] + c1[r];
            l += ls;
            pvt(oacc, (lptr)lds + L_V + (i & 1) * 8192, c0, c1, lane, hi);
        }
        *(LAS u32x4*)(lds + L_K + (i & 1) * 8192 + wid * 1024 + lane * 16) = krS;
        *(LAS u32x4*)(lds + L_V + ((i + 1) & 1) * 8192 + wid * 1024 + lane * 16) = vrS;
        __syncthreads();
    };
    for (int i = 0; i < nt; i += 2) {
        step(i, sa0, sa1, sb0, sb1, krA, vrA, krB, vrB);
        if (i + 1 < nt) step(i + 1, sb0, sb1, sa0, sa1, krB, vrB, krA, vrA);
    }
}
}

__device__ __forceinline__ void phase_nsa_mfma(const Params& p, LAS unsigned char* lds, int bid, int nb) {
    using namespace nsa2;
    int tid_ = threadIdx.x; asm volatile("" : "+v"(tid_));
    const int tid = tid_, lane = tid & 63, wid = __builtin_amdgcn_readfirstlane(tid >> 6), r32 = lane & 31, hi = lane >> 5;
    bf16_t* NQ = (bf16_t*)(p.ws + WS_NQ); const bf16_t* NKV = (const bf16_t*)(p.ws + WS_NKV);
    const bf16_t* KC = (const bf16_t*)(p.ws + WS_KC); const bf16_t* VC = (const bf16_t*)(p.ws + WS_VC); const float* SM = (const float*)(p.ws + WS_SM);
    LAS float* IA = (LAS float*)(lds + L_IA); LAS float* IB = (LAS float*)(lds + L_IB);
    const float gq = wave_max(fabsf(p.nsa_q_norm[lane])), gks = wave_max(fabsf(p.nsa_k_norm[64 + lane])), gkw = wave_max(fabsf(p.nsa_k_norm[128 + lane]));
    const float Bs = 11.54156f * 1.02f * gq * gks, Bw = 11.54156f * 1.02f * gq * gkw;
    const bool fast = __builtin_amdgcn_readfirstlane((int)((Bs < 60.f) && (Bw < 60.f))) != 0;
    unsigned* ctr = (unsigned*)(p.ws + 16384);
    int e_next = 0;
    if (tid == 0) e_next = (int)atomicAdd(ctr, 1u);
    for (;;) {
        __syncthreads();
        if (threadIdx.x == 0) *(LAS int*)(lds + L_CTR) = e_next;
        __syncthreads();
        const int e = *(LAS const int*)(lds + L_CTR);
        if (e >= 1024) break;
        const int blk = 127 - (e >> 3), bh = e & 7, b = bh >> 2, h = bh & 3;
        int tid_i = tid_; asm volatile("" : "+v"(tid_i));
        const int tid = tid_i, lane = tid & 63, r32 = lane & 31, hi = lane >> 5;
        const int t0 = blk * 64, tl = 8 * wid + (r32 >> 2), g = r32 & 3, t = t0 + tl;
        const int tg = b * SEQ + t;
        const int qoff = tg * 1024 + (4 * h + g) * 64;
        const lptr qr = (lptr)lds + L_Q + tid * 16;
        const int goff = tg * 64 + 16 + (4 * h + g) * 3;
        f32x16 ot[2];
        u32x4 kr, vr;
        const int kofc = tile_koff(64, wid, lane), vofc = tile_voff(64, wid, lane), kofs = tile_koff(1536, wid, lane), vofs = tile_voff(1536, wid, lane);
        const bf16_t* kcb = KC + (size_t)(b * 4 + h) * 512 * 64; const bf16_t* vcb = VC + (size_t)(b * 4 + h) * 512 * 64;
        const int nvmax = min(NCMP, 4 * blk + 3), ntc = (nvmax + 63) >> 6;
        const int nvq = (t >= 31) ? min(NCMP, (t - 31) / 16 + 1) : 0;
        float m = -INFINITY, l = 0.f;
        {
            bf16x8 qv[4];
#pragma unroll
            for (int d0 = 0; d0 < 4; ++d0) qv[d0] = *(const bf16x8*)(NQ + qoff + 16 * d0 + 8 * hi);
            tile_load(kr, vr, kcb, vcb, kofc, vofc);
#pragma unroll
            for (int d0 = 0; d0 < 4; ++d0) *(LAS bf16x8*)(lds + L_Q + d0 * 8192 + tid * 16) = qv[d0];
            tile_store(lds, 0, kr, vr, wid, lane);
        }
        const float graw0 = SM[goff], graw1 = SM[goff + 1], graw2 = SM[goff + 2];
        __syncthreads();
        for (int i = 0; i < ntc; ++i) {
            { const int inx = (i + 1 < ntc) ? i + 1 : 0; tile_load(kr, vr, kcb + (size_t)inx * 4096, vcb + (size_t)inx * 4096, kofc, vofc); }
            f32x16 p0, p1; qkt(p0, p1, (lptr)lds + L_K + (i & 1) * 8192, qr, r32, hi);
            const int n0 = 64 * i;
            const int nl = nvq - n0 - 4 * hi;
#pragma unroll
            for (int r = 0; r < 16; ++r) { p0[r] = (crow(r, 0) < nl) ? p0[r] : -INFINITY; p1[r] = (crow(r, 0) + 32 < nl) ? p1[r] : -INFINITY; }
            const float mx = tile_max(p0, p1), mn = fmaxf(m, mx), mu = (mn == -INFINITY) ? 0.f : mn;
            float ls = 0.f;
#pragma unroll
            for (int r = 0; r < 16; ++r) ls += __builtin_amdgcn_exp2f(p0[r] - mu) + __builtin_amdgcn_exp2f(p1[r] - mu);
            l = l * __builtin_amdgcn_exp2f(m - mu) + ls; m = mn;
            tile_store(lds, (i + 1) & 1, kr, vr, wid, lane);
            __syncthreads();
        }
        {
            const float lt = l + __shfl_xor(l, 32), linv = lt > 0.f ? 1.f / lt : 0.f, mu = (m == -INFINITY) ? 0.f : m;
            const float gate_c = sigmoidf_(graw0);
            f32x16 oc[2];
#pragma unroll
            for (int r = 0; r < 16; ++r) { oc[0][r] = 0.f; oc[1][r] = 0.f; }
            for (int i = 0; i < ntc; ++i) {
                const int sl = (ntc + i) & 1;
                if (i + 1 < ntc) tile_load(kr, vr, kcb + (size_t)(i + 1) * 4096, vcb + (size_t)(i + 1) * 4096, kofc, vofc);
                f32x16 p0, p1; qkt(p0, p1, (lptr)lds + L_K + sl * 8192, qr, r32, hi);
                const int n0 = 64 * i, nl = nvq - n0 - 4 * hi;
#pragma unroll
                for (int r = 0; r < 16; ++r) {
                    p0[r] = (crow(r, 0) < nl) ? __builtin_amdgcn_exp2f(p0[r] - mu) * linv : 0.f; p1[r] = (crow(r, 0) + 32 < nl) ? __builtin_amdgcn_exp2f(p1[r] - mu) * linv : 0.f; }
#pragma unroll
                for (int a = 0; a < 4; ++a) {
                    float A0 = p0[4 * a] + p0[4 * a + 1] + p0[4 * a + 2] + 0.5f * p0[4 * a + 3], B0 = 0.5f * p0[4 * a + 3];
                    float A1 = p1[4 * a] + p1[4 * a + 1] + p1[4 * a + 2] + 0.5f * p1[4 * a + 3], B1 = 0.5f * p1[4 * a + 3];
                    A0 = quad_sum(A0); B0 = quad_sum(B0); A1 = quad_sum(A1); B1 = quad_sum(B1);
                    const int s = (n0 >> 2) + 2 * a + hi;
                    if (g == 0) { IA[tl * IP + s] = A0; IB[tl * IP + s] = B0; IA[tl * IP + s + 8] = A1; IB[tl * IP + s + 8] = B1; }
                }
                pvt(oc, (lptr)lds + L_V + sl * 8192, p0, p1, lane, hi);
                if (i + 1 < ntc) tile_store(lds, sl ^ 1, kr, vr, wid, lane);
                __syncthreads();
            }
#pragma unroll
            for (int r = 0; r < 16; ++r) { ot[0][r] = gate_c * oc[0][r]; ot[1][r] = gate_c * oc[1][r]; }
        }
        const bf16_t* kbs = NKV + (size_t)b * SEQ * 1536 + 2 * 256 + h * 64;
        u32x4 pk0, pv0, pk1;
        fast_first<0>(pk0, pv0, pk1, kbs, kbs + 256, kofs, vofs, blk);
        unsigned long long mylo = 0ull, myhi = 0ull;
        {
            unsigned long long flo = 1ull, fhi = 0ull; int nforced = 1;
            if (blk >= 2) { const int s = blk - 1; if (s < 64) flo |= 1ull << s; else fhi |= 1ull << (s - 64); ++nforced; }
            if (blk >= 1) { const int s = blk; if (s < 64) flo |= 1ull << s; else fhi |= 1ull << (s - 64); ++nforced; }
            const int need = 16 - nforced, ncand = blk - 2;
            mylo = flo; myhi = fhi;
            if (ncand > 0) {
                const int k8 = lane >> 3, s8 = lane & 7, tk = 8 * wid + k8;
                unsigned u[16]; unsigned vbits = 0u;
#pragma unroll
                for (int j = 0; j < 16; ++j) { const int c = s8 + 8 * j; const bool v = (c >= 1) && (c <= blk - 2);
                    const float a = IA[tk * IP + c], b2 = IB[tk * IP + (c >= 1 ? c - 1 : 0)];
                    u[j] = v ? __float_as_uint(a + b2) : 0u; vbits |= (v ? 1u : 0u) << j; }
                unsigned selbits;
                if (ncand <= need) selbits = vbits;
                else {
                    unsigned T = 0u; bool done = false;
                    for (int bit = 30; bit >= 0; --bit) {
                        const unsigned cc = T | (1u << bit);
                        int cnt = 0;
#pragma unroll
                        for (int j = 0; j < 16; ++j) cnt += (u[j] >= cc) ? 1 : 0;
                        cnt = group8_sum(cnt);
                        if (!done) { if (cnt >= need) T = cc; if (cnt == need) { done = true; T = cc - 1u; } }
                        if (__all(done)) break;
                    }
                    int gt = 0; selbits = 0u;
#pragma unroll
                    for (int j = 0; j < 16; ++j) { const bool g1 = u[j] > T; gt += g1 ? 1 : 0; selbits |= (g1 ? 1u : 0u) << j; }
                    const int rem = need - group8_sum(gt);
                    if (__any(rem > 0)) {
                        int run = 0;
#pragma unroll
                        for (int j = 0; j < 16; ++j) { const bool eq = ((vbits >> j) & 1u) && (u[j] == T);
                            const unsigned long long bq = __ballot(eq);
                            const unsigned grp = (unsigned)(bq >> (8 * k8)) & 0xffu;
                            if (eq && (run + __popc(grp & ((1u << s8) - 1u)) < rem)) selbits |= 1u << j;
                            run += __popc(grp); }
                    }
                }
#pragma unroll
                for (int j = 0; j < 16; ++j) { const unsigned long long bs = __ballot(((selbits >> j) & 1u) != 0u);
                    const unsigned long long byte = (bs >> (8 * (r32 >> 2))) & 0xffull;
                    if (j < 8) mylo |= byte << (8 * j); else myhi |= byte << (8 * (j - 8)); }
            }
        }
        __syncthreads();
        LAS float* OT = (LAS float*)(lds + L_IA);
#pragma unroll
        for (int r = 0; r < 16; ++r) { OT[r * 512 + tid] = ot[0][r]; OT[(16 + r) * 512 + tid] = ot[1][r]; }
        {
            const bf16_t* kb = NKV + (size_t)b * SEQ * 1536 + 2 * 256 + h * 64; const bf16_t* vb = kb + 256;
            f32x16 os[2];
#pragma unroll
            for (int r = 0; r < 16; ++r) { os[0][r] = 0.f; os[1][r] = 0.f; }
            m = -INFINITY; l = 0.f;
            if (fast) fast_loop<0>(lds, kb, vb, kofs, vofs, blk, tl, t, mylo, myhi, Bs, qr, os, l, wid, lane, r32, hi, pk0, pv0, pk1);
            else {
            tile_load(kr, vr, kb, vb, kofs, vofs); tile_store(lds, 0, kr, vr, wid, lane);
            __syncthreads();
            for (int j = 0; j <= blk; ++j) {
                if (j < blk) tile_load(kr, vr, kb + (size_t)(j + 1) * 64 * 1536, vb + (size_t)(j + 1) * 64 * 1536, kofs, vofs);
                const bool sel = (j < 64) ? ((mylo >> j) & 1ull) : ((myhi >> (j - 64)) & 1ull);
                if (__any(sel)) {
                    f32x16 p0, p1;
                    {
                        qkt(p0, p1, (lptr)lds + L_K + (j & 1) * 8192, qr, r32, hi);
                        const int lim = (sel ? ((j == blk) ? tl : 63) : -1) - 4 * hi;
#pragma unroll
                        for (int r = 0; r < 16; ++r) { p0[r] = (crow(r, 0) <= lim) ? p0[r] : -INFINITY; p1[r] = (crow(r, 0) + 32 <= lim) ? p1[r] : -INFINITY; }
                        osm_step(p0, p1, m, l, os, (lptr)lds + L_V + (j & 1) * 8192, lane, hi);
                    }
                }
                if (j < blk) tile_store(lds, (j + 1) & 1, kr, vr, wid, lane);
                __syncthreads();
            }
            }
            fast_first<1>(pk0, pv0, pk1, kbs + 512, kbs + 768, kofs, vofs, blk);
            const float lt = l + __shfl_xor(l, 32), sc = sigmoidf_(graw1) * (lt > 0.f ? 1.f / lt : 0.f);
#pragma unroll
            for (int r = 0; r < 16; ++r) { OT[r * 512 + tid] += sc * os[0][r]; OT[(16 + r) * 512 + tid] += sc * os[1][r]; }
        }
        {
            const bf16_t* kb = NKV + (size_t)b * SEQ * 1536 + 4 * 256 + h * 64; const bf16_t* vb = kb + 256;
            f32x16 ow[2];
#pragma unroll
            for (int r = 0; r < 16; ++r) { ow[0][r] = 0.f; ow[1][r] = 0.f; }
            m = -INFINITY; l = 0.f;
            const int jlo = max(0, blk - 8), nt = blk - jlo + 1;
            if (fast) fast_loop<1>(lds, kb, vb, kofs, vofs, blk, tl, t, mylo, myhi, Bw, qr, ow, l, wid, lane, r32, hi, pk0, pv0, pk1);
            else {
            tile_load(kr, vr, kb + (size_t)blk * 64 * 1536, vb + (size_t)blk * 64 * 1536, kofs, vofs); tile_store(lds, 0, kr, vr, wid, lane);
            __syncthreads();
            for (int i = 0; i < nt; ++i) {
                const int j = (i == 0) ? blk : jlo + i - 1;
                if (i + 1 < nt) { const int jn = jlo + i; tile_load(kr, vr, kb + (size_t)jn * 64 * 1536, vb + (size_t)jn * 64 * 1536, kofs, vofs); }
                f32x16 p0, p1;
                const int klo = t - 511 - 64 * j - 4 * hi, khi = t - 64 * j - 4 * hi;
                {
                    qkt(p0, p1, (lptr)lds + L_K + (i & 1) * 8192, qr, r32, hi);
#pragma unroll
                    for (int r = 0; r < 16; ++r) { const int kk = crow(r, 0); p0[r] = (kk >= klo && kk <= khi) ? p0[r] : -INFINITY; p1[r] = (kk + 32 >= klo && kk + 32 <= khi) ? p1[r] : -INFINITY; }
                    osm_step(p0, p1, m, l, ow, (lptr)lds + L_V + (i & 1) * 8192, lane, hi);
                }
                if (i + 1 < nt) tile_store(lds, (i + 1) & 1, kr, vr, wid, lane);
                __syncthreads();
            }
            }
            const float lt = l + __shfl_xor(l, 32), sc = sigmoidf_(graw2) * (lt > 0.f ? 1.f / lt : 0.f);
#pragma unroll
            for (int r = 0; r < 16; ++r) { ot[0][r] = OT[r * 512 + tid] + sc * ow[0][r]; ot[1][r] = OT[(16 + r) * 512 + tid] + sc * ow[1][r]; }
        }
        if (threadIdx.x == 0) e_next = (int)atomicAdd(ctr, 1u);
        {
            LAS unsigned char* ost = lds + L_K + wid * 4096;
            const int k8 = r32 >> 2;
#pragma unroll
            for (int d0 = 0; d0 < 2; ++d0)
#pragma unroll
                for (int a = 0; a < 4; ++a) { u32x2 w; w.x = pk(ot[d0][4 * a], ot[d0][4 * a + 1]); w.y = pk(ot[d0][4 * a + 2], ot[d0][4 * a + 3]);
                    *(LAS u32x2*)(ost + k8 * 512 + ((g * 128 + 64 * d0 + 16 * a + 8 * hi) ^ (k8 << 4))) = w; }
            asm volatile("s_waitcnt lgkmcnt(0)" ::: "memory");
            bf16_t* orow = NQ + (size_t)(b * SEQ + t0 + 8 * wid) * 1024 + 4 * h * 64;
#pragma unroll
            for (int i = 0; i < 4; ++i) { const int pi = lane + 64 * i, rk = pi >> 5, j = pi & 31;
                const u32x4 w = *(LAS const u32x4*)(ost + rk * 512 + ((16 * j) ^ (rk << 4)));
                *(u32x4*)(orow + (size_t)rk * 1024 + j * 8) = w; }
            asm volatile("s_waitcnt lgkmcnt(0)" ::: "memory");
        }
    }
}

__device__ __forceinline__ Params kparams() {
#if defined(__HIP_DEVICE_COMPILE__)
    auto k = __builtin_amdgcn_kernarg_segment_ptr();
    asm volatile("" : "+s"(k));
    return *(const Params __attribute__((address_space(4)))*)k;
#else
    return Params{};
#endif
}
__global__ void __launch_bounds__(NTHREADS, 2) mega(Params p_unused) {
    cg::grid_group grid = cg::this_grid();
    extern __shared__ __attribute__((aligned(16))) unsigned char lds[];
    float* sm = (float*)lds;
    LAS unsigned char* lds3 = (LAS unsigned char*)lds;
    const int bid = blockIdx.x, nb = gridDim.x;
    volatile LAS unsigned* xst = (volatile LAS unsigned*)(lds3 + LDS_BYTES - 16);
    if (threadIdx.x < 4) xst[threadIdx.x] = 0u;
    __syncthreads();
    { const Params p = kparams(); (void)xcd_barrier_post((unsigned*)p.ws, xst); }
#define GRID_BAR() do { const Params pb_ = kparams(); XcdBarrier xb_; xb_.bar = (unsigned*)pb_.ws; xb_.x = xb_xcc_id(); xb_.st = (volatile LAS unsigned*)(lds3 + LDS_BYTES - 16); xcd_barrier(xb_); } while (0)
    { const Params p = kparams();
      phase_prep(p, bid, nb);
      phase_convert(p, sm, bid, nb); }
    grid.sync();
    {
        const Params p = kparams(); const char* BT = (const char*)(p.ws + WS_BT);
        pg8::Gemm g{1024}; SchedEarly S{(const char*)p.out, BT, nb, bid}; EpiEarly E{p.ws, lds3, (bf16_t*)((unsigned char*)p.out + OUT_UV), p.nsa_q_norm, p.nsa_k_norm, p.pe_k, p.pe_v, p.mem_q_norm, p.mem_k_norm};
        pg8::gemm_phase<EpiEarly, SchedEarly, true, true>(lds3, g, S, E);
    }
    GRID_BAR();
    if (bid < 32) {
        const Params p = kparams();
        pg8::Gemm g{2048}; SchedCmp S{(const char*)(p.ws + WS_UK), (const char*)p.out + OUT_UV, (const char*)(p.ws + WS_BTC), bid}; EpiCmp E{(bf16_t*)(p.ws + WS_H1)};
        pg8::gemm_phase<EpiCmp, SchedCmp, true, true>(lds3, g, S, E);
        __syncthreads();
        compress_stage2(p, bid);
    }
    {
        const Params p = kparams();
        unsigned* ctr2 = (unsigned*)(p.ws + 16384 + 1024);
        phase_memattn_lds(p, lds3, ctr2);
        phase_gla_prepass(p, sm, ctr2 + 64);
    }
    GRID_BAR();
    if (bid < 32) { const Params p = kparams(); gla_main(p, lds3, bid); }
    { const Params p = kparams(); phase_nsa_mfma(p, lds3, bid, nb); }
    GRID_BAR();
    {
        const Params p = kparams(); const char* BT = (const char*)(p.ws + WS_BT);
        pg8::Gemm g{1024}; SchedPlain S{(const char*)p.out, BT + (size_t)R_G * 2048, 12, 768, nb, bid}; EpiGates E{p.ws};
        pg8::gemm_phase<EpiGates, SchedPlain, true, true>(lds3, g, S, E);
    }
    GRID_BAR();
    {
        const Params p = kparams(); const char* BT = (const char*)(p.ws + WS_BT);
        pg8::Gemm g{1024};
        SchedMix S{(const char*)p.out, (const char*)(p.ws + WS_GV), (const char*)(p.ws + WS_NQ), (const char*)(p.ws + WS_MQ), BT + (size_t)R_M * 2048, BT + (size_t)R_B * 2048, nb, bid};
        EpiMix E{p.ws};
        pg8::gemm_phase<EpiMix, SchedMix, true, true>(lds3, g, S, E);
    }
    GRID_BAR();
    {
        const Params p = kparams(); const char* BT = (const char*)(p.ws + WS_BT);
        pg8::Gemm g{1024}; SchedPlain S{(const char*)(p.ws + WS_GQK), BT + (size_t)R_O * 2048, 4, 256, nb, bid}; EpiOut E{p.x, p.out};
        pg8::gemm_phase<EpiOut, SchedPlain, true, true>(lds3, g, S, E);
    }
}
#undef GRID_BAR

extern "C" void kernel_launch(void* const* d_in, const int* in_sizes, int n_in, void* d_out, int out_size, void* d_ws, size_t ws_size, hipStream_t stream) {
    static int grid_blocks = 0;
    if (grid_blocks == 0) {
        if (n_in != 22 || in_sizes[0] != M * DM || out_size != M * DM || ws_size < WS_END2) {
            fprintf(stderr, "kernel_launch: unexpected shapes n_in %d in0 %d out %d ws %zu\n", n_in, n_in > 0 ? in_sizes[0] : -1, out_size, ws_size); grid_blocks = -1; return; }
        int dev = 0, cus = 0, per_cu = 0;
        hipGetDevice(&dev);
        hipDeviceGetAttribute(&cus, hipDeviceAttributeMultiprocessorCount, dev);
        hipFuncSetAttribute((const void*)mega, hipFuncAttributeMaxDynamicSharedMemorySize, LDS_BYTES);
        hipOccupancyMaxActiveBlocksPerMultiprocessor(&per_cu, (const void*)mega, NTHREADS, LDS_BYTES);
        if (per_cu < 1) { fprintf(stderr, "kernel_launch: occupancy query says %d blocks per CU\n", per_cu); per_cu = 1; }
        grid_blocks = cus * per_cu;
        fprintf(stderr, "kernel_launch: %d CUs x %d = grid %d\n", cus, per_cu, grid_blocks);
    }
    if (grid_blocks < 0) return;
    Params p{};
    p.x = (const float*)d_in[0]; p.mem = (const float*)d_in[1]; p.pos = (const int*)d_in[2]; p.norm_gain = (const float*)d_in[3]; p.mem_norm_gain = (const float*)d_in[4];
    p.w_in = (const float*)d_in[5]; p.w_alpha = (const float*)d_in[6]; p.b_alpha = (const float*)d_in[7]; p.gla_out_norm = (const float*)d_in[8]; p.nsa_q_norm = (const float*)d_in[9];
    p.nsa_k_norm = (const float*)d_in[10]; p.pe_k = (const float*)d_in[11]; p.pe_v = (const float*)d_in[12]; p.wk1 = (const float*)d_in[13]; p.wk2 = (const float*)d_in[14];
    p.wv1 = (const float*)d_in[15]; p.wv2 = (const float*)d_in[16]; p.w_mem_kv = (const float*)d_in[17]; p.mem_q_norm = (const float*)d_in[18]; p.mem_k_norm = (const float*)d_in[19];
    p.w_branch = (const float*)d_in[20]; p.w_out = (const float*)d_in[21];
    p.out = (float*)d_out; p.ws = (unsigned char*)d_ws;
    if (hipMemsetAsync(d_ws, 0, 32768, stream) != hipSuccess) { fprintf(stderr, "kernel_launch: memset of the barrier words failed\n"); return; }
    void* args[] = {&p};
    hipError_t e = hipLaunchCooperativeKernel((const void*)mega, dim3(grid_blocks), dim3(NTHREADS), args, LDS_BYTES, stream);
    if (e != hipSuccess) fprintf(stderr, "cooperative launch failed: %s (grid %d)\n", hipGetErrorString(e), grid_blocks);
}
```

```cpp
#include <hip/hip_runtime.h>
#include <hip/hip_cooperative_groups.h>
#include <cstdio>
#include <cstdint>
namespace cg = cooperative_groups;

constexpr int NB = 2, SEQ = 8192, DM = 1024, M = NB * SEQ;
constexpr int DIN = 11840;
constexpr int C_GQ = 0, C_GK = 512, C_GV = 1024, C_LR = 2048, C_GG = 2064, C_NQ = 3088, C_NKV = 4112, C_NG = 5648,
              C_NGATE = 5696, C_MQ = 6720, C_MGATE = 7744, C_MERGE = 8768;
constexpr int NMEM = 256, NCMP = 511;
constexpr float EPS = 1e-6f;
constexpr int NTHREADS = 512, NWAVES = 8;
constexpr int LDS_BYTES = 147456;

constexpr size_t MiB = 1u << 20;
constexpr size_t WS_SM = 1 * MiB;
constexpr size_t WS_COS = 5 * MiB;
constexpr size_t WS_SIN = 7 * MiB;
constexpr size_t WS_KC = 9 * MiB;
constexpr size_t WS_VC = 11 * MiB;
constexpr size_t WS_MK = 13 * MiB;
constexpr size_t WS_MV = 15 * MiB;
constexpr size_t WS_RSTD = 17 * MiB;
constexpr size_t WS_MEMN = 18 * MiB;
constexpr size_t WS_GQK = 20 * MiB;
constexpr size_t WS_GV = 52 * MiB;
constexpr size_t WS_NQ = 84 * MiB;
constexpr size_t WS_NKV = 116 * MiB;
constexpr size_t WS_MQ = 164 * MiB;
constexpr size_t WS_END = 196 * MiB;
constexpr size_t WS_MKB = WS_KC + 1 * MiB;
constexpr size_t WS_MVT = WS_VC + 1 * MiB;

typedef unsigned short bf16_t;
__device__ __forceinline__ float bf2f(bf16_t v) { return __uint_as_float(((unsigned)v) << 16); }
__device__ __forceinline__ bf16_t f2bf(float f) { unsigned u = __float_as_uint(f); return (bf16_t)((u + 0x7fffu + ((u >> 16) & 1u)) >> 16); }
__device__ __forceinline__ float wave_sum(float v) {
#pragma unroll
    for (int o = 1; o < 64; o <<= 1) v += __shfl_xor(v, o);
    return v;
}
__device__ __forceinline__ float wave_max(float v) {
#pragma unroll
    for (int o = 1; o < 64; o <<= 1) v = fmaxf(v, __shfl_xor(v, o));
    return v;
}
__device__ __forceinline__ float sigmoidf_(float x) { return 1.f / (1.f + expf(-x)); }
__device__ __forceinline__ float fsig(float x) { return __builtin_amdgcn_rcpf(1.f + __builtin_amdgcn_exp2f(-1.4426950408889634f * x)); }
__device__ __forceinline__ float fsilu(float x) { return x * fsig(x); }

struct Params {
    const float* x; const float* mem; const int* pos; const float* norm_gain; const float* mem_norm_gain; const float* w_in;
    const float* w_alpha; const float* b_alpha; const float* gla_out_norm; const float* nsa_q_norm; const float* nsa_k_norm;
    const float* pe_k; const float* pe_v; const float* wk1; const float* wk2; const float* wv1; const float* wv2;
    const float* w_mem_kv; const float* mem_q_norm; const float* mem_k_norm; const float* w_branch; const float* w_out;
    float* out; unsigned char* ws;
};


constexpr int R_E = 0;
constexpr int R_SMALL = 5632;
constexpr int R_MKV = 5888;
constexpr int R_G = 7936;
constexpr int R_M = 11008;
constexpr int R_B = 14080;
constexpr int R_O = 17152;
constexpr int R_END = 18176;
constexpr size_t WS_BT = 196 * MiB;
constexpr size_t WS_END2 = WS_BT + (size_t)R_END * 1024 * 2;
static_assert(WS_END2 <= 256 * MiB, "workspace map");
constexpr size_t WS_UK = 232 * MiB;
constexpr size_t OUT_UV = 33 * MiB;
constexpr size_t WS_H1 = 248 * MiB;
constexpr size_t WS_W2T = 254 * MiB;
constexpr size_t WS_BTC = 252 * MiB;
static_assert(WS_END2 <= WS_UK, "workspace map");
constexpr size_t WS_GSCR = WS_NKV;

#define LAS __attribute__((address_space(3)))
typedef float f32x4 __attribute__((ext_vector_type(4)));
typedef unsigned u32x4 __attribute__((ext_vector_type(4)));
typedef unsigned u32x2 __attribute__((ext_vector_type(2)));

namespace pg8 {
#define PG8_LAS __attribute__((address_space(3)))
typedef unsigned short bf16_t;
typedef short bf16x8 __attribute__((ext_vector_type(8)));
typedef float f32x4 __attribute__((ext_vector_type(4)));
typedef unsigned u32x4 __attribute__((ext_vector_type(4)));
constexpr int BM = 256, BK = 64, HALF = 128, HTB = HALF * BK * 2  , STAGE_BYTES = 8 * HTB, NXCD = 8, WGM = 8;

__host__ __device__ __forceinline__ int lds_byte(int r, int c) { const int st = (r >> 4) * 2 + (c >> 5), rr = r & 15, cc = c & 31, ob = rr * 64 + cc * 2; return st * 1024 + (ob ^ (((ob >> 9) & 1) << 5)); }
__host__ __device__ __forceinline__ void stage_rc(int b, int& R, int& C) { const int st = b / 1024, sb = b % 1024, swz = sb ^ (((sb >> 9) & 1) << 5); R = (st >> 1) * 16 + swz / 64; C = (st & 1) * 32 + (swz % 64) / 2; }
__host__ __device__ __forceinline__ int perm32(int rho) { const int n = rho >> 4, i = rho & 15; return 8 * (i >> 2) + 4 * n + (i & 3); }

struct Unit { int pm, pn, tag; };
struct Gemm { int K; };
typedef float f32x2_cv __attribute__((ext_vector_type(2))); typedef __bf16 bf16x2_cv __attribute__((ext_vector_type(2)));
__device__ __forceinline__ unsigned cvt_pk_bf16(float lo, float hi) { const f32x2_cv v = {lo, hi}; return __builtin_bit_cast(unsigned, __builtin_convertvector(v, bf16x2_cv)); }
template <class Epi, class Sched, bool ALIGN_EPI = false, bool SP2 = false>
__device__ __forceinline__ void gemm_phase(PG8_LAS unsigned char* lds, const Gemm g, const Sched& S, const Epi& E) {
    int tid_ = threadIdx.x; asm volatile("" : "+v"(tid_));
    const int tid = tid_, wid = __builtin_amdgcn_readfirstlane(tid >> 6), lane = tid & 63, wr = wid >> 2, wc = wid & 3, fr = lane & 15, fq = lane >> 4;
    const int K = g.K, nt = K / BK;
    unsigned voffA[2], voffB[2];
#pragma unroll
    for (int i = 0; i < 2; ++i) { int R, C; stage_rc(tid * 16 + i * 8192, R, C); const int Rb = Epi::PERM ? ((R & ~31) + perm32(R & 31)) : R;
        voffA[i] = (unsigned)(R * K + C) * 2u; voffB[i] = (unsigned)(Rb * K + C) * 2u; }
    const size_t kstep = (size_t)(BK * 2);
    const size_t hstep = (size_t)HALF * K * 2;
    const size_t tstep = 2 * hstep;
    const unsigned ldsw = (unsigned)wid * 1024u;
    const int aoff = lds_byte(wr * 64 + fr, fq * 8), boff = lds_byte(wc * 32 + fr, fq * 8);
#define PG8_SA(b, h) (((b) * 2 + (h)) * HTB)
#define PG8_SB(b, h) ((4 + (b) * 2 + (h)) * HTB)
#define PG8_STAGE(bufoff, gbase, voff) do { _Pragma("unroll") for (int _i = 0; _i < 2; ++_i) \
        __builtin_amdgcn_global_load_lds((const unsigned*)((const char*)(gbase) + (voff)[_i]), (PG8_LAS unsigned*)(lds + (bufoff) + ldsw + _i * 8192), 16, 0, 0); } while (0)
#define PG8_LDA(dst, b, h) do { _Pragma("unroll") for (int m = 0; m < 4; ++m) _Pragma("unroll") for (int k = 0; k < 2; ++k) dst[m][k] = *(const PG8_LAS bf16x8*)(lds + PG8_SA(b, h) + aoff + m * 2048 + k * 1024); } while (0)
#define PG8_LDB(dst, b, h) do { _Pragma("unroll") for (int n = 0; n < 2; ++n) _Pragma("unroll") for (int k = 0; k < 2; ++k) dst[n][k] = *(const PG8_LAS bf16x8*)(lds + PG8_SB(b, h) + boff + n * 2048 + k * 1024); } while (0)
#define PG8_MMA(ai, bj, At, Bt) do { __builtin_amdgcn_s_setprio(1); _Pragma("unroll") for (int m = 0; m < 4; ++m) _Pragma("unroll") for (int n = 0; n < 2; ++n) _Pragma("unroll") for (int k = 0; k < 2; ++k) \
        acc[ai][bj][m][n] = __builtin_amdgcn_mfma_f32_16x16x32_bf16(Bt[n][k], At[m][k], acc[ai][bj][m][n], 0, 0, 0); __builtin_amdgcn_s_setprio(0); } while (0)
#define PG8_WAIT_V(n) asm volatile("s_waitcnt vmcnt(" #n ")" ::: "memory")
#define PG8_WAIT_L(n) asm volatile("s_waitcnt lgkmcnt(" #n ")" ::: "memory")
#define PG8_BAR __builtin_amdgcn_s_barrier()
#define PG8_SCHED __builtin_amdgcn_sched_barrier(0)
    Unit cur, nxt; int ui = 0;
    if (!S.next(0, cur)) return;
    f32x4 acc[2][2][4][2];
#pragma unroll
    for (int a = 0; a < 2; ++a)
#pragma unroll
        for (int b = 0; b < 2; ++b)
#pragma unroll
            for (int m = 0; m < 4; ++m)
#pragma unroll
                for (int n = 0; n < 2; ++n) acc[a][b][m][n] = (f32x4){0.f, 0.f, 0.f, 0.f};
    bf16x8 At[4][2], B0[2][2], B1[2][2];
    const char* cA = S.pa(cur); const char* cB = S.pb(cur);
    S.a_ready(cur);
    if constexpr (SP2) {
        PG8_STAGE(PG8_SB(0, 0), cB, voffB); PG8_STAGE(PG8_SB(0, 1), cB + hstep, voffB); PG8_STAGE(PG8_SA(0, 0), cA, voffA); PG8_STAGE(PG8_SA(0, 1), cA + hstep, voffA);
        if (wr == 1) PG8_BAR;
        PG8_WAIT_V(2); PG8_BAR;
        PG8_STAGE(PG8_SB(1, 0), cB + kstep, voffB); PG8_STAGE(PG8_SA(1, 0), cA + kstep, voffA); PG8_STAGE(PG8_SB(1, 1), cB + hstep + kstep, voffB);
        PG8_WAIT_V(6); PG8_BAR;
    } else {
        PG8_STAGE(PG8_SB(0, 0), cB, voffB); PG8_STAGE(PG8_SA(0, 0), cA, voffA); PG8_STAGE(PG8_SB(0, 1), cB + hstep, voffB); PG8_STAGE(PG8_SA(0, 1), cA + hstep, voffA);
        if (wr == 1) PG8_BAR;
        PG8_WAIT_V(4); PG8_BAR;
        PG8_STAGE(PG8_SB(1, 0), cB + kstep, voffB); PG8_STAGE(PG8_SA(1, 0), cA + kstep, voffA); PG8_STAGE(PG8_SB(1, 1), cB + hstep + kstep, voffB);
        PG8_WAIT_V(6); PG8_BAR;
    }
    for (;;) {
        const bool has_next = S.next(ui + 1, nxt);
        const char* nA = has_next ? S.pa(nxt) : cA; const char* nB = has_next ? S.pb(nxt) : cB;
        for (int t = 0; t < nt; t += 2) {
            const bool last = (t == nt - 2);
            const char* a1 = cA + (size_t)(t + 1) * kstep;
            const char* a2 = last ? nA : cA + (size_t)(t + 2) * kstep; const char* b2 = last ? nB : cB + (size_t)(t + 2) * kstep;
            const char* a3 = a2 + kstep; const char* b3 = b2 + kstep;
            if (last && has_next) S.a_ready(nxt);
            if constexpr (SP2) {
            PG8_LDB(B0, 0, 0); PG8_LDB(B1, 0, 1); PG8_SCHED; PG8_LDA(At, 0, 0); PG8_STAGE(PG8_SA(1, 1), a1 + hstep, voffA);
            PG8_WAIT_V(8); PG8_WAIT_L(0); PG8_BAR; PG8_MMA(0, 0, At, B0); PG8_MMA(0, 1, At, B1); PG8_BAR; PG8_SCHED;
            PG8_LDA(At, 0, 1); PG8_STAGE(PG8_SB(0, 0), b2, voffB); PG8_STAGE(PG8_SB(0, 1), b2 + hstep, voffB); PG8_STAGE(PG8_SA(0, 0), a2, voffA);
            PG8_WAIT_V(8); PG8_WAIT_L(0); PG8_BAR; PG8_MMA(1, 0, At, B0); PG8_MMA(1, 1, At, B1); PG8_BAR; PG8_SCHED;
            PG8_LDB(B0, 1, 0); PG8_LDB(B1, 1, 1); PG8_SCHED; PG8_LDA(At, 1, 0); PG8_STAGE(PG8_SA(0, 1), a2 + hstep, voffA);
            PG8_WAIT_V(8); PG8_WAIT_L(0); PG8_BAR; PG8_MMA(0, 0, At, B0); PG8_MMA(0, 1, At, B1); PG8_BAR; PG8_SCHED;
            PG8_LDA(At, 1, 1); PG8_STAGE(PG8_SB(1, 0), b3, voffB); PG8_STAGE(PG8_SB(1, 1), b3 + hstep, voffB); PG8_STAGE(PG8_SA(1, 0), a3, voffA);
            PG8_WAIT_V(8); PG8_WAIT_L(0); PG8_BAR; PG8_MMA(1, 0, At, B0); PG8_MMA(1, 1, At, B1); PG8_BAR; PG8_SCHED;
            } else {
            PG8_LDB(B0, 0, 0); PG8_SCHED; PG8_LDA(At, 0, 0); PG8_STAGE(PG8_SA(1, 1), a1 + hstep, voffA);
            PG8_WAIT_L(8); PG8_BAR; PG8_WAIT_L(0); PG8_MMA(0, 0, At, B0); PG8_BAR; PG8_SCHED;
            PG8_LDB(B1, 0, 1); PG8_STAGE(PG8_SB(0, 0), b2, voffB);
            PG8_BAR; PG8_WAIT_L(0); PG8_MMA(0, 1, At, B1); PG8_BAR;
            PG8_LDA(At, 0, 1); PG8_STAGE(PG8_SA(0, 0), a2, voffA);
            PG8_BAR; PG8_WAIT_L(0); PG8_MMA(1, 0, At, B0); PG8_BAR; PG8_SCHED;
            PG8_STAGE(PG8_SB(0, 1), b2 + hstep, voffB);
            PG8_WAIT_V(6); PG8_BAR; PG8_MMA(1, 1, At, B1); PG8_BAR;
            PG8_LDB(B0, 1, 0); PG8_SCHED; PG8_LDA(At, 1, 0); PG8_STAGE(PG8_SA(0, 1), a2 + hstep, voffA);
            PG8_WAIT_L(8); PG8_BAR; PG8_WAIT_L(0); PG8_MMA(0, 0, At, B0); PG8_BAR; PG8_SCHED;
            PG8_LDB(B1, 1, 1); PG8_STAGE(PG8_SB(1, 0), b3, voffB);
            PG8_BAR; PG8_WAIT_L(0); PG8_MMA(0, 1, At, B1); PG8_BAR;
            PG8_LDA(At, 1, 1); PG8_STAGE(PG8_SA(1, 0), a3, voffA);
            PG8_BAR; PG8_WAIT_L(0); PG8_MMA(1, 0, At, B0); PG8_BAR; PG8_SCHED;
            PG8_STAGE(PG8_SB(1, 1), b3 + hstep, voffB);
            PG8_WAIT_V(6); PG8_BAR; PG8_MMA(1, 1, At, B1); PG8_BAR;
            }
        }
        if constexpr (ALIGN_EPI) { if (wr == 0) PG8_BAR; }
        if constexpr (!Epi::AFTER_DRAIN) { E(acc, cur, wr, wc, fr, fq); S.done(cur); }
        if (!has_next) break;
#pragma unroll
        for (int a = 0; a < 2; ++a)
#pragma unroll
            for (int b = 0; b < 2; ++b)
#pragma unroll
                for (int m = 0; m < 4; ++m)
#pragma unroll
                    for (int n = 0; n < 2; ++n) acc[a][b][m][n] = (f32x4){0.f, 0.f, 0.f, 0.f};
        cur = nxt; cA = nA; cB = nB; ++ui;
        if constexpr (ALIGN_EPI) { if (wr == 1) PG8_BAR; }
    }
    PG8_WAIT_V(0);
    if constexpr (!ALIGN_EPI) { if (wr == 0) PG8_BAR; }
    PG8_BAR;
    if constexpr (Epi::AFTER_DRAIN) { E.fused(acc, cur, wr, wc, fr, fq, lds, wid, lane); S.done(cur); }
#undef PG8_SA
#undef PG8_SB
#undef PG8_STAGE
#undef PG8_LDA
#undef PG8_LDB
#undef PG8_MMA
#undef PG8_WAIT_V
#undef PG8_WAIT_L
#undef PG8_BAR
#undef PG8_SCHED
}
}

#define RLX_AGENT __ATOMIC_RELAXED, __HIP_MEMORY_SCOPE_AGENT
#define XB_TMO      128
#define XB_XCNT(j)  (256  + 64 * (j))
#define XB_XSUB(j)  (1280 + 64 * (j))
#define XB_XGEN(j)  (2304 + 64 * (j))
#define XB_TOP      3328
#define XB_TOPGEN   3392
#define XCD_BAR_WORDS 3456
#define XB_SPIN_CAP (1u << 18)

__device__ __forceinline__ unsigned xb_ld(unsigned* p)              { return __hip_atomic_load(p, __ATOMIC_RELAXED, __HIP_MEMORY_SCOPE_AGENT); }
__device__ __forceinline__ unsigned xb_add(unsigned* p, unsigned v) { return __hip_atomic_fetch_add(p, v, __ATOMIC_RELAXED, __HIP_MEMORY_SCOPE_AGENT); }
__device__ __forceinline__ unsigned xb_xcc_id() { return (unsigned)__builtin_amdgcn_s_getreg((3 << 11) | 20) & 0xFu; }
#define XB_SPIN(cond, bar) do { unsigned _sp = 0; while (cond) { __builtin_amdgcn_s_sleep(1); \
    if ((++_sp & 255u) == 0u) { if (xb_ld(&(bar)[XB_TMO])) break; if (_sp > XB_SPIN_CAP) { atomicAdd(&(bar)[XB_TMO], 1u); break; } } } } while (0)

struct XcdBarrier {
    unsigned* bar; unsigned x;
    volatile LAS unsigned* st;
};

__device__ __forceinline__ XcdBarrier xcd_barrier_post(unsigned* bar, volatile LAS unsigned* st) {
    XcdBarrier b; b.bar = bar; b.x = xb_xcc_id(); b.st = st;
    if (threadIdx.x == 0) (void)xb_add(&bar[XB_XCNT(b.x)], 1u);
    return b;
}
__device__ __forceinline__ void xcd_barrier_complete(unsigned* bar, unsigned x, unsigned& nloc, unsigned& nx) {
    const unsigned G = gridDim.x * gridDim.y * gridDim.z;
    unsigned sum, cnt, mine, sp = 0u;
    for (;;) {
        sum = 0u; cnt = 0u; mine = 0u;
#pragma unroll
        for (unsigned j = 0; j < 16; ++j) { const unsigned c = xb_ld(&bar[XB_XCNT(j)]); sum += c; cnt += (c > 0u) ? 1u : 0u; mine = (j == x) ? c : mine; }
        if (sum == G) break;
        __builtin_amdgcn_s_sleep(1);
        if ((++sp & 255u) == 0u) { if (xb_ld(&bar[XB_TMO])) break; if (sp > XB_SPIN_CAP) { atomicAdd(&bar[XB_TMO], 1u); break; } }
    }
    nloc = mine > 0u ? mine : 1u; nx = cnt > 0u ? cnt : 1u;
}

__device__ __forceinline__ void xcd_barrier(const XcdBarrier& b) {
    asm volatile("s_waitcnt vmcnt(0)" ::: "memory");
    __syncthreads();
    if (threadIdx.x == 0) {
        unsigned* bar = b.bar;
        __builtin_amdgcn_s_waitcnt(0);
        unsigned nloc = b.st[0], nx = b.st[1];
        if (nloc == 0u) { xcd_barrier_complete(bar, b.x, nloc, nx); b.st[0] = nloc; b.st[1] = nx; }
        const unsigned old = xb_add(&bar[XB_XSUB(b.x)], 1u);
        const unsigned gen = old / nloc;
        if (old + 1u == (gen + 1u) * nloc) {
            __builtin_amdgcn_fence(__ATOMIC_RELEASE, "agent");
            asm volatile("s_waitcnt vmcnt(0)" ::: "memory");
            const unsigned og = xb_add(&bar[XB_TOP], 1u);
            const unsigned tg = og / nx;
            if (og + 1u == (tg + 1u) * nx) xb_add(&bar[XB_TOPGEN], 1u);
            else XB_SPIN(xb_ld(&bar[XB_TOPGEN]) == tg, bar);
            __builtin_amdgcn_fence(__ATOMIC_ACQUIRE, "agent");
            xb_add(&bar[XB_XGEN(b.x)], 1u);
            asm volatile("s_waitcnt vmcnt(0)" ::: "memory");
        } else {
            XB_SPIN(xb_ld(&bar[XB_XGEN(b.x)]) == gen, bar);
            __builtin_amdgcn_fence(__ATOMIC_ACQUIRE, "agent");
            asm volatile("s_waitcnt vmcnt(0)" ::: "memory");
        }
    }
    __syncthreads();
}

struct SchedEarly {
    const char* A; const char* B; int G, c;
    static constexpr int nM = 64, nN = 23, nwg = nM * nN, nx = 16;
    __device__ __forceinline__ bool next(int i, pg8::Unit& u) const {
        const int L = i * G + c; if (L >= nwg + nx) return false;
        if (L >= nwg) { const int e = L - nwg; u.pm = 64 + (e >> 3); u.pn = 23 + (e & 7); u.tag = 1; return true; }
        int wgid = L; { const int q = nwg / 8, xcd = wgid % 8, off = wgid / 8; wgid = xcd * q + off; }
        const int nig = 8 * nN, gid = wgid / nig, fm = gid * 8;
        const int s = (wgid % nig) / 8;
        const unsigned long long tab = s < 12 ? 0x5a928398a418820ull : 0x5272ada2f6c1ccull;
        u.pm = fm + ((wgid % nig) % 8); u.pn = (int)((tab >> (5 * (s < 12 ? s : s - 12))) & 31u); u.tag = 0; return true;
    }
    __device__ __forceinline__ const char* pa(const pg8::Unit& u) const { return A + (size_t)u.pm * (256 * 1024 * 2); }
    __device__ __forceinline__ const char* pb(const pg8::Unit& u) const { return B + (size_t)u.pn * (256 * 1024 * 2); }
    __device__ __forceinline__ void a_ready(const pg8::Unit&) const {}
    __device__ __forceinline__ void done(const pg8::Unit&) const {}
};
struct SchedPlain {
    const char* A; const char* B; int nN, nwg, G, c;
    __device__ __forceinline__ bool next(int i, pg8::Unit& u) const {
        const int L = i * G + c; if (L >= nwg) return false;
        int wgid = L; { const int q = nwg / 8, xcd = wgid % 8, off = wgid / 8; wgid = xcd * q + off; }
        const int nig = 8 * nN, gid = wgid / nig, fm = gid * 8;
        u.pm = fm + ((wgid % nig) % 8); u.pn = (wgid % nig) / 8; u.tag = 0; return true;
    }
    __device__ __forceinline__ const char* pa(const pg8::Unit& u) const { return A + (size_t)u.pm * (256 * 1024 * 2); }
    __device__ __forceinline__ const char* pb(const pg8::Unit& u) const { return B + (size_t)u.pn * (256 * 1024 * 2); }
    __device__ __forceinline__ void a_ready(const pg8::Unit&) const {}
    __device__ __forceinline__ void done(const pg8::Unit&) const {}
};
struct SchedMix {
    const char* XN; const char* Y0; const char* Y1; const char* Y2; const char* BM_; const char* BB; int G, c;
    __device__ __forceinline__ bool next(int i, pg8::Unit& u) const {
        const int tl = (i / 6) * G + c; if (tl >= 256) return false;
        int wgid = tl; { const int xcd = wgid % 8, off = wgid / 8; wgid = xcd * 32 + off; }
        const int gid = wgid / 32, fm = gid * 8;
        u.pm = fm + ((wgid % 32) % 8); u.pn = (wgid % 32) / 8; u.tag = i % 6; return true;
    }
    __device__ __forceinline__ const char* pa(const pg8::Unit& u) const {
        const int cc = u.tag >> 1; const char* base = (u.tag & 1) ? (cc == 0 ? Y0 : (cc == 1 ? Y1 : Y2)) : XN;
        return base + (size_t)u.pm * (256 * 1024 * 2); }
    __device__ __forceinline__ const char* pb(const pg8::Unit& u) const {
        const int cc = u.tag >> 1; return ((u.tag & 1) ? BB : BM_) + (size_t)(cc * 4 + u.pn) * (256 * 1024 * 2); }
    __device__ __forceinline__ void a_ready(const pg8::Unit&) const {}
    __device__ __forceinline__ void done(const pg8::Unit&) const {}
};

__device__ __forceinline__ float fq_sum(float x) {
    const auto r = __builtin_amdgcn_permlane16_swap(__float_as_uint(x), __float_as_uint(x), false, false);
    const float s = __uint_as_float(r[0]) + __uint_as_float(r[1]);
    const auto q = __builtin_amdgcn_permlane32_swap(__float_as_uint(s), __float_as_uint(s), false, false);
    return __uint_as_float(q[0]) + __uint_as_float(q[1]);
}
struct EpiEarly {
    static constexpr bool PERM = true, AFTER_DRAIN = false;
    unsigned char* ws; PG8_LAS unsigned char* lds; bf16_t* UV;
    const float* nsa_q_norm; const float* nsa_k_norm; const float* pe_k; const float* pe_v; const float* mem_q_norm; const float* mem_k_norm;
    static constexpr int XS = 131072;
    __device__ __forceinline__ void operator()(const pg8::f32x4 (&acc)[2][2][4][2], const pg8::Unit& u, int wr, int wc, int fr_, int fq_) const {
        int fr = fr_, fq = fq_; asm volatile("" : "+v"(fr), "+v"(fq));
        const int pn = u.pn;
        const bool headtile = (pn >= 8 && pn < 15) || pn == 16;
        if (pn < 8 || pn == 15 || pn == 17) {
            bf16_t* base; int ldc = 1024, colt; float sc = 1.f;
            if (pn < 4) { base = (bf16_t*)(ws + WS_GQK); colt = pn * 256; if (pn < 2) sc = 0.08838834764831845f; }
            else if (pn < 8) { base = (bf16_t*)(ws + WS_GV); colt = (pn - 4) * 256; }
            else { base = (bf16_t*)(ws + WS_NKV); colt = (pn - 12) * 256; ldc = 1536; }
            const int row0 = u.pm * 256 + wr * 64 + fr, col0 = colt + wc * 32 + 8 * fq;
#pragma unroll
            for (int ai = 0; ai < 2; ++ai)
#pragma unroll
                for (int m = 0; m < 4; ++m) { bf16_t* rowp = base + (size_t)(row0 + ai * 128 + m * 16) * ldc + col0;
#pragma unroll
                    for (int bj = 0; bj < 2; ++bj) { const pg8::f32x4 v0 = acc[ai][bj][m][0] * sc, v1 = acc[ai][bj][m][1] * sc; u32x4 w;
                        w.x = pg8::cvt_pk_bf16(v0[0], v0[1]); w.y = pg8::cvt_pk_bf16(v0[2], v0[3]); w.z = pg8::cvt_pk_bf16(v1[0], v1[1]); w.w = pg8::cvt_pk_bf16(v1[2], v1[3]);
                        *(u32x4*)(rowp + bj * 128) = w; } }
        } else if (headtile) {
            const bool isq = pn < 12, isv = pn == 13, iscmp = (pn == 12 || pn == 13);
            const float* gn = isq ? nsa_q_norm : (nsa_k_norm + ((pn - 12) >> 1) * 64);
            const float osc = isq ? 0.125f * 1.4426950408889634f : 1.f;
            float ga[8], gb[8];
            { const f32x4 g0 = *(const f32x4*)(gn + 8 * fq), g1 = *(const f32x4*)(gn + 8 * fq + 4), g2 = *(const f32x4*)(gn + 32 + 8 * fq), g3 = *(const f32x4*)(gn + 36 + 8 * fq);
#pragma unroll
              for (int e = 0; e < 4; ++e) { ga[e] = g0[e] * osc; ga[4 + e] = g1[e] * osc; gb[e] = g2[e] * osc; gb[4 + e] = g3[e] * osc; } }
            const float* COS = (const float*)(ws + WS_COS); const float* SIN = (const float*)(ws + WS_SIN);
            bf16_t* obase = isq ? ((bf16_t*)(ws + WS_NQ) + (pn - 8) * 256) : ((bf16_t*)(ws + WS_NKV) + (pn - 12) * 256);
            const int ldc = isq ? 1024 : 1536;
            bf16_t* U = isv ? UV : (bf16_t*)(ws + WS_UK); const float* pe = isv ? pe_v : pe_k;
            const int row0 = u.pm * 256 + wr * 64 + fr;
            f32x4 tb[2][4];
#define EE_LDT(r, d) do { const size_t to_ = (size_t)(row0 + ((r) >> 2) * 128 + ((r) & 3) * 16) * 32 + 8 * fq; d[0] = *(const f32x4*)(COS + to_); d[1] = *(const f32x4*)(COS + to_ + 4); d[2] = *(const f32x4*)(SIN + to_); d[3] = *(const f32x4*)(SIN + to_ + 4); } while (0)
            if (!isv) EE_LDT(0, tb[0]);
#pragma unroll
            for (int r = 0; r < 8; ++r) {
                    const int ai = r >> 2, m = r & 3;
                    const int t = row0 + ai * 128 + m * 16;
                    if (!isv && r < 7) EE_LDT(r + 1, tb[(r + 1) & 1]);
                    const pg8::f32x4 x0 = acc[ai][0][m][0], x1 = acc[ai][0][m][1], y0 = acc[ai][1][m][0], y1 = acc[ai][1][m][1];
                    float a[8] = {x0[0], x0[1], x0[2], x0[3], x1[0], x1[1], x1[2], x1[3]};
                    float b[8] = {y0[0], y0[1], y0[2], y0[3], y1[0], y1[1], y1[2], y1[3]};
                    if (!isv) {
                        float ss = 0.f;
#pragma unroll
                        for (int e = 0; e < 8; ++e) ss += a[e] * a[e] + b[e] * b[e];
                        const float rs = rsqrtf(fq_sum(ss) * (1.f / 64.f) + EPS);
                        const f32x4 c0 = tb[r & 1][0], c1 = tb[r & 1][1], s0 = tb[r & 1][2], s1 = tb[r & 1][3];
#pragma unroll
                        for (int e = 0; e < 8; ++e) { const float cc = (e < 4 ? c0[e & 3] : c1[e & 3]) * rs, sn = (e < 4 ? s0[e & 3] : s1[e & 3]) * rs;
                            const float ya = a[e] * ga[e], yb = b[e] * gb[e]; a[e] = ya * cc - yb * sn; b[e] = yb * cc + ya * sn; }
                    }
                    if (!iscmp) {
                        bf16_t* op = obase + (size_t)t * ldc + wc * 64 + 8 * fq; u32x4 oa, ob;
                        oa.x = pg8::cvt_pk_bf16(a[0], a[1]); oa.y = pg8::cvt_pk_bf16(a[2], a[3]); oa.z = pg8::cvt_pk_bf16(a[4], a[5]); oa.w = pg8::cvt_pk_bf16(a[6], a[7]);
                        ob.x = pg8::cvt_pk_bf16(b[0], b[1]); ob.y = pg8::cvt_pk_bf16(b[2], b[3]); ob.z = pg8::cvt_pk_bf16(b[4], b[5]); ob.w = pg8::cvt_pk_bf16(b[6], b[7]);
                        *(u32x4*)op = oa; *(u32x4*)(op + 32) = ob;
                    } else {
                        const int bb = t / SEQ, ts = t % SEQ, n1 = ts >> 4;
#pragma unroll
                        for (int rep = 0; rep < 2; ++rep) {
                            const int n = n1 - rep, ll = fr + 16 * rep;
                            if (n >= 0 && n < NCMP) {
                                const float* pp = pe + ll * 64 + 8 * fq;
                                const f32x4 pa0 = *(const f32x4*)pp, pa1 = *(const f32x4*)(pp + 4), pb0 = *(const f32x4*)(pp + 32), pb1 = *(const f32x4*)(pp + 36);
                                u32x4 oa, ob;
                                oa.x = pg8::cvt_pk_bf16(a[0] + pa0[0], a[1] + pa0[1]); oa.y = pg8::cvt_pk_bf16(a[2] + pa0[2], a[3] + pa0[3]); oa.z = pg8::cvt_pk_bf16(a[4] + pa1[0], a[5] + pa1[1]); oa.w = pg8::cvt_pk_bf16(a[6] + pa1[2], a[7] + pa1[3]);
                                ob.x = pg8::cvt_pk_bf16(b[0] + pb0[0], b[1] + pb0[1]); ob.y = pg8::cvt_pk_bf16(b[2] + pb0[2], b[3] + pb0[3]); ob.z = pg8::cvt_pk_bf16(b[4] + pb1[0], b[5] + pb1[1]); ob.w = pg8::cvt_pk_bf16(b[6] + pb1[2], b[7] + pb1[3]);
                                bf16_t* up = U + ((size_t)(bb * NCMP + n) * 4 + wc) * 2048 + ll * 64 + 8 * fq;
                                *(u32x4*)up = oa; *(u32x4*)(up + 32) = ob;
                            }
                        }
                    }
            }
#undef EE_LDT
        } else if (pn == 22) {
            if (wc < 2) { float* SM = (float*)(ws + WS_SM); const int row0 = u.pm * 256 + wr * 64 + fr, col0 = wc * 32 + 8 * fq;
#pragma unroll
                for (int ai = 0; ai < 2; ++ai)
#pragma unroll
                    for (int m = 0; m < 4; ++m) { float* rowp = SM + (size_t)(row0 + ai * 128 + m * 16) * 64 + col0;
                        *(pg8::f32x4*)(rowp) = acc[ai][0][m][0]; *(pg8::f32x4*)(rowp + 4) = acc[ai][0][m][1]; } }
        } else if (pn >= 27) {
            bf16_t* MVT = (bf16_t*)(ws + WS_MVT) + (size_t)((u.pm - 64) * 4 + (pn - 27)) * 65536;
            const int m0 = wr * 64 + fr, d0 = wc * 32 + 8 * fq;
#pragma unroll
            for (int ai = 0; ai < 2; ++ai)
#pragma unroll
                for (int m = 0; m < 4; ++m)
#pragma unroll
                    for (int bj = 0; bj < 2; ++bj)
#pragma unroll
                        for (int e = 0; e < 8; ++e) MVT[(size_t)(d0 + bj * 128 + e) * 256 + m0 + ai * 128 + m * 16] = f2bf(acc[ai][bj][m][e >> 2][e & 3]);
        } else {
            const bool isk = pn >= 23;
            PG8_LAS float* xs = (PG8_LAS float*)(lds + XS) + wr * 512;
            float ssr[8];
#pragma unroll
            for (int ai = 0; ai < 2; ++ai)
#pragma unroll
                for (int m = 0; m < 4; ++m) { float ss = 0.f;
#pragma unroll
                    for (int bj = 0; bj < 2; ++bj)
#pragma unroll
                        for (int n = 0; n < 2; ++n) { const pg8::f32x4 v = acc[ai][bj][m][n]; ss += v[0] * v[0] + v[1] * v[1] + v[2] * v[2] + v[3] * v[3]; }
                    ss = fq_sum(ss);
                    if (fq == 0) xs[(ai * 64 + m * 16 + fr) * 4 + wc] = ss; }
            asm volatile("s_waitcnt lgkmcnt(0)" ::: "memory"); __builtin_amdgcn_s_barrier(); asm volatile("" ::: "memory");
#pragma unroll
            for (int ai = 0; ai < 2; ++ai)
#pragma unroll
                for (int m = 0; m < 4; ++m) { const f32x4 q4 = *(const PG8_LAS f32x4*)(xs + (ai * 64 + m * 16 + fr) * 4); ssr[ai * 4 + m] = q4[0] + q4[1] + q4[2] + q4[3]; }
            const float* gn = isk ? mem_k_norm : mem_q_norm; const float osc = isk ? 1.f : 0.0625f * 1.4426950408889634f;
            const int c0 = wc * 32 + 8 * fq;
            bf16_t* obase = isk ? ((bf16_t*)(ws + WS_MKB) + (size_t)((u.pm - 64) * 4 + (pn - 23)) * 65536) : ((bf16_t*)(ws + WS_MQ) + (size_t)u.pm * 256 * 1024 + (pn - 18) * 256);
            const int ldc = isk ? 256 : 1024;
#pragma unroll
            for (int bj = 0; bj < 2; ++bj) {
                const f32x4 g0 = *(const f32x4*)(gn + c0 + bj * 128) * osc, g1 = *(const f32x4*)(gn + c0 + bj * 128 + 4) * osc;
#pragma unroll
                for (int ai = 0; ai < 2; ++ai)
#pragma unroll
                    for (int m = 0; m < 4; ++m) { const float rs = rsqrtf(ssr[ai * 4 + m] * (1.f / 256.f) + EPS);
                        const pg8::f32x4 v0 = acc[ai][bj][m][0] * rs * g0, v1 = acc[ai][bj][m][1] * rs * g1; u32x4 w;
                        w.x = pg8::cvt_pk_bf16(v0[0], v0[1]); w.y = pg8::cvt_pk_bf16(v0[2], v0[3]); w.z = pg8::cvt_pk_bf16(v1[0], v1[1]); w.w = pg8::cvt_pk_bf16(v1[2], v1[3]);
                        *(u32x4*)(obase + (size_t)(wr * 64 + fr + ai * 128 + m * 16) * ldc + c0 + bj * 128) = w; }
            }
        }
    }
};
__device__ __forceinline__ float bflo(unsigned w) { return __uint_as_float(w << 16); }
__device__ __forceinline__ float bfhi(unsigned w) { return __uint_as_float(w & 0xffff0000u); }
struct EpiGates {
    static constexpr bool PERM = true, AFTER_DRAIN = false;
    unsigned char* ws;
    template <bool GLA>
    __device__ __forceinline__ void run(const pg8::f32x4 (&acc)[2][2][4][2], const pg8::Unit& u, int wr, int wc, int fr, int fq) const {
        const int pn = u.pn; const int br = pn >> 2;
        bf16_t* base = (bf16_t*)(ws + (GLA ? WS_GV : (br == 1 ? WS_NQ : WS_MQ)));
        const float* RSTD = (const float*)(ws + WS_RSTD);
        const int row0 = u.pm * 256 + wr * 64 + fr, col0 = (pn & 3) * 256 + wc * 32 + 8 * fq;
#pragma unroll
        for (int am = 0; am < 4; ++am) {
            const int ai = am >> 1, m0 = (am & 1) * 2;
            u32x4 ov[2][2]; f32x4 q4[2];
#pragma unroll
            for (int mm = 0; mm < 2; ++mm) { const int row = row0 + ai * 128 + (m0 + mm) * 16; const bf16_t* rowp = base + (size_t)row * 1024 + col0;
                ov[mm][0] = *(const u32x4*)rowp; ov[mm][1] = *(const u32x4*)(rowp + 128);
                if (GLA) q4[mm] = *(const f32x4*)(RSTD + (size_t)row * 16 + pn * 4); }
            __builtin_amdgcn_sched_barrier(0);
#pragma unroll
            for (int mm = 0; mm < 2; ++mm) { const int m = m0 + mm; const int row = row0 + ai * 128 + m * 16; bf16_t* rowp = base + (size_t)row * 1024 + col0;
                float rs = 1.f;
                if (GLA) rs = rsqrtf((q4[mm][0] + q4[mm][1] + q4[mm][2] + q4[mm][3]) * (1.f / 256.f) + EPS);
#pragma unroll
                for (int bj = 0; bj < 2; ++bj) { const u32x4 o = ov[mm][bj]; const pg8::f32x4 a0 = acc[ai][bj][m][0], a1 = acc[ai][bj][m][1];
                    u32x4 w;
                    w.x = pg8::cvt_pk_bf16(bflo(o.x) * rs * fsilu(a0[0]), bfhi(o.x) * rs * fsilu(a0[1]));
                    w.y = pg8::cvt_pk_bf16(bflo(o.y) * rs * fsilu(a0[2]), bfhi(o.y) * rs * fsilu(a0[3]));
                    w.z = pg8::cvt_pk_bf16(bflo(o.z) * rs * fsilu(a1[0]), bfhi(o.z) * rs * fsilu(a1[1]));
                    w.w = pg8::cvt_pk_bf16(bflo(o.w) * rs * fsilu(a1[2]), bfhi(o.w) * rs * fsilu(a1[3]));
                    *(u32x4*)(rowp + bj * 128) = w; } }
        }
    }
    __device__ __forceinline__ void operator()(const pg8::f32x4 (&acc)[2][2][4][2], const pg8::Unit& u, int wr, int wc, int fr_, int fq_) const {
        int fr = fr_, fq = fq_; asm volatile("" : "+v"(fr), "+v"(fq));
        if ((u.pn >> 2) == 0) run<true>(acc, u, wr, wc, fr, fq); else run<false>(acc, u, wr, wc, fr, fq);
    }
};
struct EpiMix {
    static constexpr bool PERM = true, AFTER_DRAIN = false;
    unsigned char* ws;
    template <bool ACCUM>
    __device__ __forceinline__ void run1(const pg8::f32x4 (&acc)[2][2][4][2], const pg8::Unit& u, int wr, int wc, int fr, int fq) const {
        const bf16_t* scr = (const bf16_t*)(ws + WS_GSCR) + (size_t)blockIdx.x * 65536;
        bf16_t* MIXED = (bf16_t*)(ws + WS_GQK);
        const int r0 = wr * 64 + fr, c0 = wc * 32 + 8 * fq;
#pragma unroll
        for (int am = 0; am < 4; ++am) {
            const int ai = am >> 1, m0 = (am & 1) * 2;
            u32x4 gv[2][2], ov[2][2];
#pragma unroll
            for (int mm = 0; mm < 2; ++mm) { const int rt = r0 + ai * 128 + (m0 + mm) * 16;
                const bf16_t* sp = scr + rt * 256 + c0; const bf16_t* mp = MIXED + (size_t)(u.pm * 256 + rt) * 1024 + u.pn * 256 + c0;
                gv[mm][0] = *(const u32x4*)sp; gv[mm][1] = *(const u32x4*)(sp + 128);
                if (ACCUM) { ov[mm][0] = *(const u32x4*)mp; ov[mm][1] = *(const u32x4*)(mp + 128); } }
            __builtin_amdgcn_sched_barrier(0);
#pragma unroll
            for (int mm = 0; mm < 2; ++mm) { const int m = m0 + mm; const int rt = r0 + ai * 128 + m * 16; bf16_t* mp = MIXED + (size_t)(u.pm * 256 + rt) * 1024 + u.pn * 256 + c0;
#pragma unroll
                for (int bj = 0; bj < 2; ++bj) { const pg8::f32x4 a0 = acc[ai][bj][m][0], a1 = acc[ai][bj][m][1]; const u32x4 g = gv[mm][bj]; u32x4 w;
                    float v[8] = {bflo(g.x) * a0[0], bfhi(g.x) * a0[1], bflo(g.y) * a0[2], bfhi(g.y) * a0[3], bflo(g.z) * a1[0], bfhi(g.z) * a1[1], bflo(g.w) * a1[2], bfhi(g.w) * a1[3]};
                    if (ACCUM) { const u32x4 o = ov[mm][bj];
                        v[0] += bflo(o.x); v[1] += bfhi(o.x); v[2] += bflo(o.y); v[3] += bfhi(o.y); v[4] += bflo(o.z); v[5] += bfhi(o.z); v[6] += bflo(o.w); v[7] += bfhi(o.w); }
                    w.x = pg8::cvt_pk_bf16(v[0], v[1]); w.y = pg8::cvt_pk_bf16(v[2], v[3]); w.z = pg8::cvt_pk_bf16(v[4], v[5]); w.w = pg8::cvt_pk_bf16(v[6], v[7]);
                    *(u32x4*)(mp + bj * 128) = w; } }
        }
    }
    __device__ __forceinline__ void operator()(const pg8::f32x4 (&acc)[2][2][4][2], const pg8::Unit& u, int wr, int wc, int fr_, int fq_) const {
        int fr = fr_, fq = fq_; asm volatile("" : "+v"(fr), "+v"(fq));
        const int kind = u.tag & 1, cc = u.tag >> 1;
        if (kind == 0) {
            bf16_t* scr = (bf16_t*)(ws + WS_GSCR) + (size_t)blockIdx.x * 65536;
            const int r0 = wr * 64 + fr, c0 = wc * 32 + 8 * fq;
#pragma unroll
            for (int ai = 0; ai < 2; ++ai)
#pragma unroll
                for (int m = 0; m < 4; ++m) { const int rt = r0 + ai * 128 + m * 16; bf16_t* sp = scr + rt * 256 + c0;
#pragma unroll
                    for (int bj = 0; bj < 2; ++bj) { const pg8::f32x4 a0 = acc[ai][bj][m][0], a1 = acc[ai][bj][m][1]; u32x4 w;
                        w.x = pg8::cvt_pk_bf16(fsig(a0[0]), fsig(a0[1])); w.y = pg8::cvt_pk_bf16(fsig(a0[2]), fsig(a0[3]));
                        w.z = pg8::cvt_pk_bf16(fsig(a1[0]), fsig(a1[1])); w.w = pg8::cvt_pk_bf16(fsig(a1[2]), fsig(a1[3]));
                        *(u32x4*)(sp + bj * 128) = w; } }
        } else if (cc == 0) run1<false>(acc, u, wr, wc, fr, fq);
        else run1<true>(acc, u, wr, wc, fr, fq);
    }
};
struct EpiOut {
    static constexpr bool PERM = false, AFTER_DRAIN = false;
    const float* x; float* out;
    __device__ __forceinline__ void operator()(const pg8::f32x4 (&acc)[2][2][4][2], const pg8::Unit& u, int wr, int wc, int fr_, int fq_) const {
        int fr = fr_, fq = fq_; asm volatile("" : "+v"(fr), "+v"(fq));
        const int row0 = u.pm * 256 + wr * 64 + fr, col0 = u.pn * 256 + wc * 32 + 4 * fq;
#pragma unroll
        for (int am = 0; am < 4; ++am) {
            const int ai = am >> 1, m0 = (am & 1) * 2;
            pg8::f32x4 xv[2][2][2];
#pragma unroll
            for (int mm = 0; mm < 2; ++mm) { const size_t off = (size_t)(row0 + ai * 128 + (m0 + mm) * 16) * 1024 + col0;
#pragma unroll
                for (int bj = 0; bj < 2; ++bj)
#pragma unroll
                    for (int n = 0; n < 2; ++n) xv[mm][bj][n] = *(const pg8::f32x4*)(x + off + bj * 128 + n * 16); }
            __builtin_amdgcn_sched_barrier(0);
#pragma unroll
            for (int mm = 0; mm < 2; ++mm) { const size_t off = (size_t)(row0 + ai * 128 + (m0 + mm) * 16) * 1024 + col0;
#pragma unroll
                for (int bj = 0; bj < 2; ++bj)
#pragma unroll
                    for (int n = 0; n < 2; ++n) *(pg8::f32x4*)(out + off + bj * 128 + n * 16) = xv[mm][bj][n] + acc[ai][bj][m0 + mm][n]; }
        }
    }
};

struct SchedCmp {
    const char* UK; const char* UV; const char* B; int u;
    __device__ __forceinline__ bool next(int i, pg8::Unit& un) const { if (i > 0) return false; un.pm = u & 15; un.pn = 0; un.tag = u >> 4; return true; }
    __device__ __forceinline__ const char* pa(const pg8::Unit& un) const { return (un.tag ? UV : UK) + (size_t)un.pm * (256 * 2048 * 2); }
    __device__ __forceinline__ const char* pb(const pg8::Unit& un) const { return B + (size_t)un.tag * (256 * 2048 * 2); }
    __device__ __forceinline__ void a_ready(const pg8::Unit&) const {}
    __device__ __forceinline__ void done(const pg8::Unit&) const {}
};
__device__ __forceinline__ float gelu_tanh_(float x) { const float u = 0.7978845608028654f * (x + 0.044715f * x * x * x); return x * fsig(2.f * u); }
struct EpiCmp {
    static constexpr bool PERM = true, AFTER_DRAIN = false;
    bf16_t* H1;
    __device__ __forceinline__ void operator()(const pg8::f32x4 (&acc)[2][2][4][2], const pg8::Unit& u, int wr, int wc, int fr, int fq) const {
        bf16_t* base = H1 + (size_t)u.tag * 4096 * 256;
        const int row0 = u.pm * 256 + wr * 64 + fr, col0 = wc * 32 + 8 * fq;
#pragma unroll
        for (int ai = 0; ai < 2; ++ai)
#pragma unroll
            for (int m = 0; m < 4; ++m) { bf16_t* rowp = base + (size_t)(row0 + ai * 128 + m * 16) * 256 + col0;
#pragma unroll
                for (int bj = 0; bj < 2; ++bj) { const pg8::f32x4 v0 = acc[ai][bj][m][0], v1 = acc[ai][bj][m][1]; u32x4 w;
                    w.x = pg8::cvt_pk_bf16(gelu_tanh_(v0[0]), gelu_tanh_(v0[1])); w.y = pg8::cvt_pk_bf16(gelu_tanh_(v0[2]), gelu_tanh_(v0[3]));
                    w.z = pg8::cvt_pk_bf16(gelu_tanh_(v1[0]), gelu_tanh_(v1[1])); w.w = pg8::cvt_pk_bf16(gelu_tanh_(v1[2]), gelu_tanh_(v1[3]));
                    *(u32x4*)(rowp + bj * 128) = w; } }
    }
};
__device__ __forceinline__ void compress_stage2(const Params& p, int u) {
    typedef short bf16x8 __attribute__((ext_vector_type(8)));
    typedef float f32x16 __attribute__((ext_vector_type(16)));
    const int tid = threadIdx.x, lane = tid & 63, wid = tid >> 6, r32 = lane & 31, hi = lane >> 5, which = u >> 4, pm = u & 15;
    const bf16_t* hrow = (const bf16_t*)(p.ws + WS_H1) + ((size_t)which * 4096 + pm * 256 + 32 * wid + r32) * 256 + 8 * hi;
    const bf16_t* wrow = (const bf16_t*)(p.ws + WS_W2T) + ((size_t)which * 64 + r32) * 256 + 8 * hi;
    f32x16 a0, a1;
#pragma unroll
    for (int r = 0; r < 16; ++r) { a0[r] = 0.f; a1[r] = 0.f; }
#pragma unroll
    for (int ks = 0; ks < 16; ++ks) {
        const bf16x8 hf = *(const bf16x8*)(hrow + 16 * ks), w0 = *(const bf16x8*)(wrow + 16 * ks), w1 = *(const bf16x8*)(wrow + 32 * 256 + 16 * ks);
        a0 = __builtin_amdgcn_mfma_f32_32x32x16_bf16(hf, w0, a0, 0, 0, 0);
        a1 = __builtin_amdgcn_mfma_f32_32x32x16_bf16(hf, w1, a1, 0, 0, 0);
    }
    bf16_t* outb = (bf16_t*)(p.ws + (which ? WS_VC : WS_KC));
#pragma unroll
    for (int r = 0; r < 16; ++r) {
        const int rr = pm * 256 + 32 * wid + (r & 3) + 8 * (r >> 2) + 4 * hi;
        if (rr < NB * NCMP * 4) {
            const int b = rr / (NCMP * 4), rem = rr % (NCMP * 4), n = rem >> 2, h = rem & 3;
            bf16_t* op = outb + ((size_t)(b * 4 + h) * 512 + n) * 64 + r32;
            op[0] = f2bf(a0[r]); op[32] = f2bf(a1[r]);
            if (n == NCMP - 1) { op[64] = 0; op[96] = 0; }
        }
    }
}

__device__ __forceinline__ const float* bt_src_col(const Params& p, int n, int& ld) {
    ld = DIN;
    if (n < 512) return p.w_in + C_GQ + n;
    if (n < 1024) return p.w_in + C_GK + (n - 512);
    if (n < 2048) return p.w_in + C_GV + (n - 1024);
    if (n < 3072) return p.w_in + C_NQ + (n - 2048);
    if (n < 4608) return p.w_in + C_NKV + (n - 3072);
    if (n < 5632) return p.w_in + C_MQ + (n - 4608);
    if (n < 5648) return p.w_in + C_LR + (n - 5632);
    if (n < 5696) return p.w_in + C_NG + (n - 5648);
    if (n < 5888) return nullptr;
    if (n < 7936) { ld = 2048; return p.w_mem_kv + (n - 5888); }
    if (n < 8960) return p.w_in + C_GG + (n - 7936);
    if (n < 9984) return p.w_in + C_NGATE + (n - 8960);
    if (n < 11008) return p.w_in + C_MGATE + (n - 9984);
    if (n < 14080) return p.w_in + C_MERGE + (n - 11008);
    ld = 1024;
    if (n < 17152) { const int e = n - 14080; return p.w_branch + (size_t)(e >> 10) * 1024 * 1024 + (e & 1023); }
    return p.w_out + (n - 17152);
}
__device__ __forceinline__ void convert_item(const float* src0, int ld, bool gather, bool perm, const float* kgain, const Params& p, int nrow0, int k0, bf16_t* dst, int K, float* tile, int tid) {
    __syncthreads();
    if (!gather) {
        const int wid = tid >> 6, lane = tid & 63;
#pragma unroll
        for (int i = 0; i < 8; ++i) { const int kk = 8 * wid + i; const float4 v = *(const float4*)(src0 + (size_t)(k0 + kk) * ld + 4 * lane);
            const float gk = kgain ? kgain[(k0 + kk) & 255] : 1.f;
            float* tp = tile + kk * 257 + 4 * lane; tp[0] = v.x * gk; tp[1] = v.y * gk; tp[2] = v.z * gk; tp[3] = v.w * gk; }
    } else {
        for (int e = tid; e < 64 * 256; e += NTHREADS) { const int kk = e >> 8, n = e & 255; int l2; const float* cp = bt_src_col(p, nrow0 + n, l2); tile[kk * 257 + n] = cp ? cp[(size_t)(k0 + kk) * l2] : 0.f; }
    }
    __syncthreads();
#pragma unroll
    for (int u = 0; u < 4; ++u) { const int pid = tid + 512 * u, n = pid >> 3, kc = pid & 7;
        const int nl = perm ? (64 * ((n >> 5) & 3) + 32 * (n >> 7) + (n & 31)) : n;
        const float* s = tile + (8 * kc) * 257 + nl;
        u32x4 o; o.x = pg8::cvt_pk_bf16(s[0], s[257]); o.y = pg8::cvt_pk_bf16(s[2 * 257], s[3 * 257]); o.z = pg8::cvt_pk_bf16(s[4 * 257], s[5 * 257]); o.w = pg8::cvt_pk_bf16(s[6 * 257], s[7 * 257]);
        *(u32x4*)(dst + (size_t)n * K + k0 + 8 * kc) = o; }
}
__device__ __forceinline__ void phase_convert(const Params& p, float* sm, int bid, int nb) {
    const int tid = threadIdx.x;
    bf16_t* BT = (bf16_t*)(p.ws + WS_BT); bf16_t* BTC = (bf16_t*)(p.ws + WS_BTC);
    constexpr int NB256 = R_END / 256, N1 = 16 * NB256, N2 = 2 * 32;
    for (int it = bid; it < N1 + N2; it += nb) {
        if (it < N1) {
            const int kb = it / NB256, nbk = it % NB256, nrow0 = 256 * nbk; int ld; const float* cp = bt_src_col(p, nrow0, ld);
            const bool perm = (nrow0 >= 2048 && nrow0 < 3840) || nrow0 == 4096;
            convert_item(cp, ld, nrow0 == R_SMALL, perm, (nrow0 >= R_B && nrow0 < R_B + 1024) ? p.gla_out_norm : nullptr, p, nrow0, 64 * kb, BT + (size_t)nrow0 * 1024, 1024, sm, tid);
        } else {
            const int r = it - N1, which = r >> 5, kb = r & 31;
            convert_item(which ? p.wv1 : p.wk1, 256, false, false, nullptr, p, 0, 64 * kb, BTC + (size_t)which * 256 * 2048, 2048, sm, tid);
        }
    }
    bf16_t* W2T = (bf16_t*)(p.ws + WS_W2T);
    for (int idx = bid * NTHREADS + tid; idx < 2 * 64 * 256; idx += nb * NTHREADS) {
        const int f = idx & 255, d = (idx >> 8) & 63, which = idx >> 14;
        W2T[idx] = f2bf((which ? p.wv2 : p.wk2)[f * 64 + d]);
    }
}

__device__ __forceinline__ int queue_pop(unsigned* ctr, LAS unsigned char* lds) {
    LAS int* slot = (LAS int*)(lds + LDS_BYTES - 64);
    __syncthreads();
    if (threadIdx.x == 0) *slot = (int)atomicAdd(ctr, 1u);
    __syncthreads();
    return *slot;
}
__device__ __forceinline__ void phase_prep(const Params& p, int bid, int nb) {
    const int tid = threadIdx.x, lane = tid & 63, wave = tid >> 6;
    const int gw = bid * NWAVES + wave, NGW = nb * NWAVES;
    bf16_t* XN = (bf16_t*)p.out;
    for (int r = gw; r < M; r += NGW) {
        const float4* xr = (const float4*)(p.x + (size_t)r * DM);
        float4 v[4]; float ss = 0.f;
#pragma unroll
        for (int j = 0; j < 4; ++j) { v[j] = xr[lane + 64 * j]; ss += v[j].x * v[j].x + v[j].y * v[j].y + v[j].z * v[j].z + v[j].w * v[j].w; }
        ss = wave_sum(ss);
        const float rs = rsqrtf(ss * (1.f / DM) + EPS);
#pragma unroll
        for (int j = 0; j < 4; ++j) {
            const float4 g = ((const float4*)p.norm_gain)[lane + 64 * j];
            u32x2 w; w.x = pg8::cvt_pk_bf16(v[j].x * rs * g.x, v[j].y * rs * g.y); w.y = pg8::cvt_pk_bf16(v[j].z * rs * g.z, v[j].w * rs * g.w);
            *(u32x2*)(XN + (size_t)r * DM + (lane + 64 * j) * 4) = w;
        }
    }
    for (int r = gw; r < NB * NMEM; r += NGW) {
        const float4* xr = (const float4*)(p.mem + (size_t)r * DM);
        float4 v[4]; float ss = 0.f;
#pragma unroll
        for (int j = 0; j < 4; ++j) { v[j] = xr[lane + 64 * j]; ss += v[j].x * v[j].x + v[j].y * v[j].y + v[j].z * v[j].z + v[j].w * v[j].w; }
        ss = wave_sum(ss);
        const float rs = rsqrtf(ss * (1.f / DM) + EPS);
#pragma unroll
        for (int j = 0; j < 4; ++j) {
            const float4 g = ((const float4*)p.mem_norm_gain)[lane + 64 * j];
            u32x2 w; w.x = pg8::cvt_pk_bf16(v[j].x * rs * g.x, v[j].y * rs * g.y); w.y = pg8::cvt_pk_bf16(v[j].z * rs * g.z, v[j].w * rs * g.w);
            *(u32x2*)(XN + (size_t)(M + r) * DM + (lane + 64 * j) * 4) = w;
        }
    }
    float* COS = (float*)(p.ws + WS_COS); float* SIN = (float*)(p.ws + WS_SIN);
    for (int idx = bid * NTHREADS + tid; idx < M * 32; idx += nb * NTHREADS) {
        const int t = idx >> 5, i = idx & 31;
        const float inv = powf(10000.0f, -(float)i / 32.0f);
        const float ang = (float)p.pos[t] * inv;
        const double ad = (double)ang, kk = rint(ad * 0.15915494309189535);
        const float red = (float)(ad - kk * 6.283185307179586);
        COS[idx] = cosf(red); SIN[idx] = sinf(red);
    }
}

constexpr size_t WS_DEC = WS_MEMN;
__device__ __forceinline__ void phase_gla_prepass(const Params& p, float* sm, unsigned* ctr) {
    const int tid = threadIdx.x, k = tid & 127, qtr = tid >> 7;
    bf16_t* GQK = (bf16_t*)(p.ws + WS_GQK); const float* SM = (const float*)(p.ws + WS_SM); float* DEC = (float*)(p.ws + WS_DEC);
    float* gl = sm;
    float* tot = sm + 64 * 128;
    for (;;) {
        const int it = queue_pop(ctr, (LAS unsigned char*)sm);
        if (it >= 1024) break;
        const int h = it & 3, bc = it >> 2, b = bc >> 7, c = bc & 127;
        const size_t tc = (size_t)b * SEQ + c * 64;
        float w[16];
#pragma unroll
        for (int r = 0; r < 16; ++r) w[r] = p.w_alpha[r * 512 + h * 128 + k];
        const float bias = p.b_alpha[h * 128 + k];
        float gcum[16]; float run = 0.f;
#pragma unroll
        for (int i = 0; i < 16; ++i) {
            const float4* lr = (const float4*)(SM + (tc + 16 * qtr + i) * 64);
            const float4 l0 = lr[0], l1 = lr[1], l2 = lr[2], l3 = lr[3];
            float z = bias + l0.x * w[0] + l0.y * w[1] + l0.z * w[2] + l0.w * w[3] + l1.x * w[4] + l1.y * w[5] + l1.z * w[6] + l1.w * w[7]
                    + l2.x * w[8] + l2.y * w[9] + l2.z * w[10] + l2.w * w[11] + l3.x * w[12] + l3.y * w[13] + l3.z * w[14] + l3.w * w[15];
            const float ez = __builtin_amdgcn_exp2f(-1.4426950408889634f * fabsf(z));
            const float ls = fminf(z, 0.f) - 0.6931471805599453f * __builtin_amdgcn_logf(1.f + ez);
            run += ls * (1.f / 16.f); gcum[i] = run;
        }
        __syncthreads();
        tot[qtr * 128 + k] = run;
        __syncthreads();
        const float s0 = tot[k], s1 = tot[128 + k], s2 = tot[256 + k], s3 = tot[384 + k];
        const float off = (qtr > 0 ? s0 : 0.f) + (qtr > 1 ? s1 : 0.f) + (qtr > 2 ? s2 : 0.f);
#pragma unroll
        for (int i = 0; i < 16; ++i) gl[(16 * qtr + i) * 128 + k] = gcum[i] + off;
        if (qtr == 0) { const float gref = s0 + s1, glast = gref + s2 + s3; float* d = DEC + (size_t)it * 384; d[k] = expf(gref); d[128 + k] = expf(glast); d[256 + k] = expf(glast - gref); }
        __syncthreads();
        {
            const int tok = tid >> 3, k0 = (tid & 7) * 16;
            bf16_t* qp = GQK + (tc + tok) * 1024 + h * 128 + k0;
#pragma unroll
            for (int hf = 0; hf < 2; ++hf) {
                const u32x4 wq = *(const u32x4*)(qp + 8 * hf), wk = *(const u32x4*)(qp + 512 + 8 * hf);
                const float qv[8] = {bflo(wq.x), bfhi(wq.x), bflo(wq.y), bfhi(wq.y), bflo(wq.z), bfhi(wq.z), bflo(wq.w), bfhi(wq.w)};
                const float kv[8] = {bflo(wk.x), bfhi(wk.x), bflo(wk.y), bfhi(wk.y), bflo(wk.z), bfhi(wk.z), bflo(wk.w), bfhi(wk.w)};
                float eq[8], ek[8];
#pragma unroll
                for (int e = 0; e < 8; ++e) { const int kk = k0 + 8 * hf + e; const float d = gl[tok * 128 + kk] - gl[31 * 128 + kk];
                    const float ex = __builtin_amdgcn_exp2f(1.4426950408889634f * d); eq[e] = qv[e] * ex; ek[e] = kv[e] * __builtin_amdgcn_rcpf(ex); }
                u32x4 oq, ok;
                oq.x = pg8::cvt_pk_bf16(eq[0], eq[1]); oq.y = pg8::cvt_pk_bf16(eq[2], eq[3]); oq.z = pg8::cvt_pk_bf16(eq[4], eq[5]); oq.w = pg8::cvt_pk_bf16(eq[6], eq[7]);
                ok.x = pg8::cvt_pk_bf16(ek[0], ek[1]); ok.y = pg8::cvt_pk_bf16(ek[2], ek[3]); ok.z = pg8::cvt_pk_bf16(ek[4], ek[5]); ok.w = pg8::cvt_pk_bf16(ek[6], ek[7]);
                *(u32x4*)(qp + 8 * hf) = oq; *(u32x4*)(qp + 512 + 8 * hf) = ok;
            }
        }
    }
}
namespace gla2 {
typedef short bf16x8 __attribute__((ext_vector_type(8)));
typedef short s16x4 __attribute__((ext_vector_type(4)));
typedef short v4i16_t __attribute__((ext_vector_type(4)));
typedef float f32x16 __attribute__((ext_vector_type(16)));
typedef LAS const unsigned char* lptr;
constexpr int CH = 1088;
constexpr int G_Q = 0, G_K = 16 * CH, G_V = 32 * CH, G_A = 40 * CH, G_S = 48 * CH, G_D = 64 * CH, G_O = G_D + 2048, OPITCH = 144;
__device__ __forceinline__ int img(int row, int col) { return (col >> 3) * CH + row * 16 + (col & 7) * 2; }
__device__ __forceinline__ int crow(int r, int hi) { return (r & 3) + 8 * (r >> 2) + 4 * hi; }
__device__ __forceinline__ s16x4 vtr(lptr p) { return __builtin_bit_cast(s16x4, __builtin_amdgcn_ds_read_tr16_b64_v4i16((LAS v4i16_t*)p)); }
__device__ __forceinline__ bf16x8 afrag(lptr base, int tile, int ks, int r32, int hi) { return *(LAS const bf16x8*)(base + (2 * ks + hi) * CH + (32 * tile + r32) * 16); }
__device__ __forceinline__ bf16x8 trfrag(lptr base, int ctile, int s, int lane) {
    const int g = lane >> 4, hi = lane >> 5, q = (lane & 15) >> 2, pp = lane & 3;
    lptr a = base + img(16 * s + 8 * hi + q, 32 * ctile + 16 * (g & 1) + 4 * pp);
    const s16x4 lo = vtr(a), hh = vtr(a + 64);
    return (bf16x8){lo[0], lo[1], lo[2], lo[3], hh[0], hh[1], hh[2], hh[3]};
}
}
__device__ __forceinline__ void gla_main(const Params& p, LAS unsigned char* lds, int item) {
    using namespace gla2;
    int tid_ = threadIdx.x; asm volatile("" : "+v"(tid_));
    const int tid = tid_, lane = tid & 63, wid = __builtin_amdgcn_readfirstlane(tid >> 6), r32 = lane & 31, hi = lane >> 5;
    const int dvq = item & 3, h = (item >> 2) & 3, b = item >> 4;
    const bf16_t* GQK = (const bf16_t*)(p.ws + WS_GQK); bf16_t* GV = (bf16_t*)(p.ws + WS_GV); const float* DEC = (const float*)(p.ws + WS_DEC);
    const lptr L = (lptr)lds;
    const int qrow0 = tid >> 4, qch = tid & 15, vrow = tid >> 3, vch = tid & 7;
    const bf16_t* qsrc = GQK + ((size_t)b * SEQ + qrow0) * 1024 + h * 128 + qch * 8;
    const bf16_t* vsrc = GV + ((size_t)b * SEQ + vrow) * 1024 + h * 256 + dvq * 64 + vch * 8;
    const float* dsrc = DEC + (size_t)(b * 128 * 4 + h) * 384 + (tid < 96 ? tid * 4 : 0);
    u32x4 rq0, rq1, rk0, rk1, rv; f32x4 rd;
#define GLA_LOAD(c) do { const size_t o_ = (size_t)(c) * 64 * 1024; rq0 = *(const u32x4*)(qsrc + o_); rq1 = *(const u32x4*)(qsrc + o_ + 32 * 1024); rk0 = *(const u32x4*)(qsrc + o_ + 512); rk1 = *(const u32x4*)(qsrc + o_ + 32 * 1024 + 512); \
        rv = *(const u32x4*)(vsrc + o_); rd = *(const f32x4*)(dsrc + (size_t)(c) * 4 * 384); } while (0)
#define GLA_BAR() do { asm volatile("s_waitcnt lgkmcnt(0)" ::: "memory"); __builtin_amdgcn_s_barrier(); asm volatile("" ::: "memory"); } while (0)
    f32x16 S;
#pragma unroll
    for (int r = 0; r < 16; ++r) S[r] = 0.f;
    const int kb = wid >> 1, vb = wid & 1;
    GLA_LOAD(0);
    { u32x4 z = {0u, 0u, 0u, 0u}; *(u32x4*)(p.ws + 262144 + (size_t)item * 8192 + tid * 16) = z; }
    for (int c = 0; c < SEQ / 64; ++c) {
        *(LAS u32x4*)(lds + G_Q + qch * CH + qrow0 * 16) = rq0; *(LAS u32x4*)(lds + G_Q + qch * CH + (qrow0 + 32) * 16) = rq1;
        *(LAS u32x4*)(lds + G_K + qch * CH + qrow0 * 16) = rk0; *(LAS u32x4*)(lds + G_K + qch * CH + (qrow0 + 32) * 16) = rk1;
        *(LAS u32x4*)(lds + G_V + vch * CH + vrow * 16) = rv;
        if (tid < 96) *(LAS f32x4*)(lds + G_D + tid * 16) = rd;
        GLA_BAR();
        GLA_LOAD(c + 1 < SEQ / 64 ? c + 1 : c);
#pragma unroll
        for (int a = 0; a < 4; ++a) {
            const int dk0 = 32 * kb + 8 * a + 4 * hi;
            const f32x4 er = *(LAS const f32x4*)(lds + G_D + dk0 * 4);
            u32x2 w; w.x = pg8::cvt_pk_bf16(S[4 * a] * er[0], S[4 * a + 1] * er[1]); w.y = pg8::cvt_pk_bf16(S[4 * a + 2] * er[2], S[4 * a + 3] * er[3]);
            *(LAS u32x2*)(lds + G_S + img(32 * vb + r32, dk0)) = w;
        }
        if (wid < 3) {
            const int tj = (wid == 2) ? 1 : 0, ti = (wid == 0) ? 0 : 1;
            f32x16 at;
#pragma unroll
            for (int r = 0; r < 16; ++r) at[r] = 0.f;
#pragma unroll
            for (int ks = 0; ks < 8; ++ks) at = __builtin_amdgcn_mfma_f32_32x32x16_bf16(afrag(L + G_K, tj, ks, r32, hi), afrag(L + G_Q, ti, ks, r32, hi), at, 0, 0, 0);
            const int lim = (ti == tj) ? (r32 - 4 * hi) : 64;
#pragma unroll
            for (int a = 0; a < 4; ++a) {
                const float v0 = (crow(4 * a, 0) <= lim) ? at[4 * a] : 0.f, v1 = (crow(4 * a + 1, 0) <= lim) ? at[4 * a + 1] : 0.f;
                const float v2 = (crow(4 * a + 2, 0) <= lim) ? at[4 * a + 2] : 0.f, v3 = (crow(4 * a + 3, 0) <= lim) ? at[4 * a + 3] : 0.f;
                u32x2 w; w.x = pg8::cvt_pk_bf16(v0, v1); w.y = pg8::cvt_pk_bf16(v2, v3);
                *(LAS u32x2*)(lds + G_A + img(32 * ti + r32, 32 * tj + 8 * a + 4 * hi)) = w;
            }
        }
        GLA_BAR();
        if (wid < 4) {
            const int ti = wid >> 1, vj = wid & 1;
            f32x16 o;
#pragma unroll
            for (int r = 0; r < 16; ++r) o[r] = 0.f;
#pragma unroll
            for (int ks = 0; ks < 8; ++ks) o = __builtin_amdgcn_mfma_f32_32x32x16_bf16(afrag(L + G_S, vj, ks, r32, hi), afrag(L + G_Q, ti, ks, r32, hi), o, 0, 0, 0);
            for (int s = 0; s < 2 * ti + 2; ++s) o = __builtin_amdgcn_mfma_f32_32x32x16_bf16(trfrag(L + G_V, vj, s, lane), afrag(L + G_A, ti, s, r32, hi), o, 0, 0, 0);
#pragma unroll
            for (int a = 0; a < 4; ++a) { u32x2 w; w.x = pg8::cvt_pk_bf16(o[4 * a], o[4 * a + 1]); w.y = pg8::cvt_pk_bf16(o[4 * a + 2], o[4 * a + 3]);
                *(LAS u32x2*)(lds + G_O + (32 * ti + r32) * OPITCH + (32 * vj + 8 * a + 4 * hi) * 2) = w; }
        }
        {
            f32x16 T;
#pragma unroll
            for (int r = 0; r < 16; ++r) T[r] = 0.f;
#pragma unroll
            for (int s = 0; s < 4; ++s) T = __builtin_amdgcn_mfma_f32_32x32x16_bf16(trfrag(L + G_K, kb, s, lane), trfrag(L + G_V, vb, s, lane), T, 0, 0, 0);
#pragma unroll
            for (int a = 0; a < 4; ++a) {
                const int dk0 = 32 * kb + 8 * a + 4 * hi;
                const f32x4 d1 = *(LAS const f32x4*)(lds + G_D + 512 + dk0 * 4), d2 = *(LAS const f32x4*)(lds + G_D + 1024 + dk0 * 4);
                S[4 * a] = d1[0] * S[4 * a] + d2[0] * T[4 * a]; S[4 * a + 1] = d1[1] * S[4 * a + 1] + d2[1] * T[4 * a + 1];
                S[4 * a + 2] = d1[2] * S[4 * a + 2] + d2[2] * T[4 * a + 2]; S[4 * a + 3] = d1[3] * S[4 * a + 3] + d2[3] * T[4 * a + 3];
            }
        }
        GLA_BAR();
        { const u32x4 w = *(LAS const u32x4*)(lds + G_O + vrow * OPITCH + vch * 16); *(u32x4*)(const_cast<bf16_t*>(vsrc) + (size_t)c * 64 * 1024) = w; }
    }
#undef GLA_LOAD
#undef GLA_BAR
    __syncthreads();
    {
        float* RSSQ = (float*)(p.ws + WS_RSTD);
        const int sub = lane >> 3, c8 = lane & 7;
        for (int r0 = wid * 8; r0 < SEQ; r0 += NWAVES * 8) {
            const int tr = r0 + sub;
            const u32x4 w = *(const u32x4*)(GV + ((size_t)b * SEQ + tr) * 1024 + h * 256 + dvq * 64 + 8 * c8);
            float ss = bflo(w.x) * bflo(w.x) + bfhi(w.x) * bfhi(w.x) + bflo(w.y) * bflo(w.y) + bfhi(w.y) * bfhi(w.y) + bflo(w.z) * bflo(w.z) + bfhi(w.z) * bfhi(w.z) + bflo(w.w) * bflo(w.w) + bfhi(w.w) * bfhi(w.w);
            ss += __shfl_xor(ss, 1); ss += __shfl_xor(ss, 2); ss += __shfl_xor(ss, 4);
            if (c8 == 0) RSSQ[((size_t)b * SEQ + tr) * 16 + h * 4 + dvq] = ss;
        }
    }
}

__device__ __forceinline__ void phase_memattn_mfma(const Params& p, int bid, int nb) {
    typedef short bf16x8 __attribute__((ext_vector_type(8)));
    typedef float f32x16 __attribute__((ext_vector_type(16)));
    int tid_ = threadIdx.x; asm volatile("" : "+v"(tid_));
    const int tid = tid_, lane = tid & 63, wave = tid >> 6, r32 = lane & 31, hi = lane >> 5;
    const int gw = bid * NWAVES + wave, NGW = nb * NWAVES;
    bf16_t* MQ = (bf16_t*)(p.ws + WS_MQ); const bf16_t* MKB = (const bf16_t*)(p.ws + WS_MKB); const bf16_t* MVT = (const bf16_t*)(p.ws + WS_MVT);
    constexpr float C2M = 1.0f;
    for (int it = gw; it < (M / 32) * 4; it += NGW) {
        const int h = it & 3, tb = it >> 2, b = tb / (SEQ / 32);
        const int qoff = (tb * 32 + r32) * 1024 + h * 256;
        const bf16_t* kb = MKB + (size_t)(b * 4 + h) * 65536; const bf16_t* vt = MVT + (size_t)(b * 4 + h) * 65536;
        f32x16 s[8];
#pragma unroll
        for (int kt = 0; kt < 8; ++kt) {
            asm volatile("" ::: "memory");
#pragma unroll
            for (int r = 0; r < 16; ++r) s[kt][r] = 0.f;
#pragma unroll
            for (int ks = 0; ks < 16; ++ks) { const bf16x8 qf = *(const bf16x8*)(MQ + qoff + 16 * ks + 8 * hi);
                const bf16x8 kf = *(const bf16x8*)(kb + (32 * kt + r32) * 256 + 16 * ks + 8 * hi); s[kt] = __builtin_amdgcn_mfma_f32_32x32x16_bf16(kf, qf, s[kt], 0, 0, 0); }
        }
        asm volatile("" ::: "memory");
        float mx = -INFINITY;
#pragma unroll
        for (int kt = 0; kt < 8; ++kt)
#pragma unroll
            for (int r = 0; r < 16; ++r) mx = fmaxf(mx, s[kt][r]);
        mx = fmaxf(mx, __shfl_xor(mx, 32)) * C2M;
        float l = 0.f;
#pragma unroll
        for (int kt = 0; kt < 8; ++kt)
#pragma unroll
            for (int r = 0; r < 16; ++r) { s[kt][r] = __builtin_amdgcn_exp2f(s[kt][r] * C2M - mx); l += s[kt][r]; }
        l += __shfl_xor(l, 32);
        const float linv = 1.f / l;
        u32x4 pw[16];
#pragma unroll
        for (int st = 0; st < 16; ++st) { const int kt = st >> 1, r0 = 8 * (st & 1);
            pw[st].x = pg8::cvt_pk_bf16(s[kt][r0] * linv, s[kt][r0 + 1] * linv); pw[st].y = pg8::cvt_pk_bf16(s[kt][r0 + 2] * linv, s[kt][r0 + 3] * linv);
            pw[st].z = pg8::cvt_pk_bf16(s[kt][r0 + 4] * linv, s[kt][r0 + 5] * linv); pw[st].w = pg8::cvt_pk_bf16(s[kt][r0 + 6] * linv, s[kt][r0 + 7] * linv); }
#pragma unroll 1
        for (int dt = 0; dt < 8; ++dt) {
            f32x16 o;
#pragma unroll
            for (int r = 0; r < 16; ++r) o[r] = 0.f;
            const bf16_t* vrow = vt + (32 * dt + r32) * 256 + 4 * hi;
#pragma unroll
            for (int st = 0; st < 16; ++st) {
                const u32x2 lo = *(const u32x2*)(vrow + 16 * st), hh = *(const u32x2*)(vrow + 16 * st + 8);
                const u32x4 vf = {lo.x, lo.y, hh.x, hh.y};
                o = __builtin_amdgcn_mfma_f32_32x32x16_bf16(__builtin_bit_cast(bf16x8, vf), __builtin_bit_cast(bf16x8, pw[st]), o, 0, 0, 0);
            }
#pragma unroll
            for (int a = 0; a < 4; ++a) { u32x2 w; w.x = pg8::cvt_pk_bf16(o[4 * a], o[4 * a + 1]); w.y = pg8::cvt_pk_bf16(o[4 * a + 2], o[4 * a + 3]);
                *(u32x2*)(MQ + qoff + 32 * dt + 8 * a + 4 * hi) = w; }
        }
    }
}
__device__ __forceinline__ void phase_memattn_lds(const Params& p, LAS unsigned char* lds, unsigned* ctr) {
    typedef short bf16x8 __attribute__((ext_vector_type(8)));
    typedef float f32x16 __attribute__((ext_vector_type(16)));
    int tid_ = threadIdx.x; asm volatile("" : "+v"(tid_));
    const int tid = tid_, lane = tid & 63, wid = __builtin_amdgcn_readfirstlane(tid >> 6), r32 = lane & 31, hi = lane >> 5;
    float gq = 0.f, gk = 0.f;
#pragma unroll
    for (int j = 0; j < 4; ++j) { gq = fmaxf(gq, fabsf(p.mem_q_norm[lane + 64 * j])); gk = fmaxf(gk, fabsf(p.mem_k_norm[lane + 64 * j])); }
    gq = wave_max(gq); gk = wave_max(gk);
    const float B = 23.0831207f * 1.02f * gq * gk;
    if (__builtin_amdgcn_readfirstlane((int)(B < 60.f)) == 0) {
        if (queue_pop(ctr, lds) < (int)gridDim.x) phase_memattn_mfma(p, blockIdx.x, gridDim.x); return; }
    bf16_t* MQ = (bf16_t*)(p.ws + WS_MQ); const bf16_t* MKB = (const bf16_t*)(p.ws + WS_MKB); const bf16_t* MVT = (const bf16_t*)(p.ws + WS_MVT);
    constexpr int KCH = 1040, VROW = 272, BUF = 36864, OSTP = 272;
#define MEM_LDK(tile) do { _Pragma("unroll") for (int u = 0; u < 4; ++u) { const int pid = tid + 512 * u; st[u] = *(const u32x4*)(kb + (64 * (tile) + (pid >> 5)) * 256 + (pid & 31) * 8); } } while (0)
#define MEM_STK(buf) do { _Pragma("unroll") for (int u = 0; u < 4; ++u) { const int pid = tid + 512 * u; *(LAS u32x4*)(lds + (buf) * BUF + (pid & 31) * KCH + (pid >> 5) * 16) = st[u]; } } while (0)
#define MEM_LDV(ph, kt) do { _Pragma("unroll") for (int u = 0; u < 4; ++u) { const int pid = tid + 512 * u; st[u] = *(const u32x4*)(vt + (128 * (ph) + (pid >> 4)) * 256 + 128 * (kt) + (pid & 15) * 8); } } while (0)
#define MEM_STV(buf) do { _Pragma("unroll") for (int u = 0; u < 4; ++u) { const int pid = tid + 512 * u; *(LAS u32x4*)(lds + (buf) * BUF + (pid >> 4) * VROW + (pid & 15) * 16) = st[u]; } } while (0)
    for (;;) {
        const int item = queue_pop(ctr, lds);
        if (item >= 256) break;
        int tidi = tid_; asm volatile("" : "+v"(tidi));
        const int tid = tidi, lane = tid & 63, r32 = lane & 31, hi = lane >> 5;
        const int bh = item >> 5, tb = item & 31, b = bh >> 2, h = bh & 3;
        const int qoff = (b * SEQ + tb * 256 + 32 * wid + r32) * 1024 + h * 256;
        const bf16_t* kb = MKB + (size_t)bh * 65536; const bf16_t* vt = MVT + (size_t)bh * 65536;
        u32x4 st[4];
        MEM_LDK(0);
        bf16x8 qf[16];
#pragma unroll
        for (int ks = 0; ks < 16; ++ks) qf[ks] = *(const bf16x8*)(MQ + qoff + 16 * ks + 8 * hi);
        MEM_STK(0); MEM_LDK(1);
        __syncthreads();
        u32x4 pw[16]; float l = 0.f;
#pragma unroll
        for (int t = 0; t < 4; ++t) {
            const LAS unsigned char* kbuf = lds + (t & 1) * BUF;
#pragma unroll
            for (int kh = 0; kh < 2; ++kh) {
                f32x16 pp;
#pragma unroll
                for (int r = 0; r < 16; ++r) pp[r] = -B;
#pragma unroll
                for (int kq = 0; kq < 2; ++kq) {
                    bf16x8 kf[8];
#pragma unroll
                    for (int i = 0; i < 8; ++i) kf[i] = *(LAS const bf16x8*)(kbuf + (2 * (8 * kq + i) + hi) * KCH + r32 * 16 + 512 * kh);
#pragma unroll
                    for (int i = 0; i < 8; ++i) pp = __builtin_amdgcn_mfma_f32_32x32x16_bf16(kf[i], qf[8 * kq + i], pp, 0, 0, 0);
                    __builtin_amdgcn_sched_group_barrier(0x100, 8, 5); __builtin_amdgcn_sched_group_barrier(0x008, 8, 5);
                }
#pragma unroll
                for (int r = 0; r < 16; ++r) { pp[r] = __builtin_amdgcn_exp2f(pp[r]); l += pp[r]; }
                u32x4 wa, wb;
                wa.x = pg8::cvt_pk_bf16(pp[0], pp[1]); wa.y = pg8::cvt_pk_bf16(pp[2], pp[3]); wa.z = pg8::cvt_pk_bf16(pp[4], pp[5]); wa.w = pg8::cvt_pk_bf16(pp[6], pp[7]);
                wb.x = pg8::cvt_pk_bf16(pp[8], pp[9]); wb.y = pg8::cvt_pk_bf16(pp[10], pp[11]); wb.z = pg8::cvt_pk_bf16(pp[12], pp[13]); wb.w = pg8::cvt_pk_bf16(pp[14], pp[15]);
                pw[4 * t + 2 * kh] = wa; pw[4 * t + 2 * kh + 1] = wb;
            }
            if (t < 3) { MEM_STK((t + 1) & 1); if (t < 2) MEM_LDK(t + 2); else MEM_LDV(0, 0); }
            else { MEM_STV(0); MEM_LDV(0, 1); }
            __syncthreads();
        }
        const float lt = l + __shfl_xor(l, 32), linv = 1.f / lt;
#pragma unroll
        for (int ph = 0; ph < 2; ++ph) {
            f32x16 o[4];
#pragma unroll
            for (int dt = 0; dt < 4; ++dt)
#pragma unroll
                for (int r = 0; r < 16; ++r) o[dt][r] = 0.f;
#pragma unroll
            for (int kt = 0; kt < 2; ++kt) {
                const LAS unsigned char* vbuf = lds + kt * BUF;
#pragma unroll
                for (int dt = 0; dt < 4; ++dt) {
                    const LAS unsigned char* vr = vbuf + (32 * dt + r32) * VROW + 8 * hi;
                    u32x2 lo[8], hh[8];
#pragma unroll
                    for (int s = 0; s < 8; ++s) { lo[s] = *(LAS const u32x2*)(vr + 32 * s); hh[s] = *(LAS const u32x2*)(vr + 32 * s + 16); }
#pragma unroll
                    for (int s = 0; s < 8; ++s) {
                        const u32x4 vf = {lo[s][0], lo[s][1], hh[s][0], hh[s][1]};
                        o[dt] = __builtin_amdgcn_mfma_f32_32x32x16_bf16(__builtin_bit_cast(bf16x8, vf), __builtin_bit_cast(bf16x8, pw[8 * kt + s]), o[dt], 0, 0, 0);
                    }
                    __builtin_amdgcn_sched_group_barrier(0x100, 16, 6); __builtin_amdgcn_sched_group_barrier(0x008, 8, 6);
                }
                const int nx = 2 * ph + kt + 1;
                if (nx < 4) { MEM_STV(nx & 1); if (nx < 3) MEM_LDV((nx + 1) >> 1, (nx + 1) & 1); __syncthreads(); }
            }
            {
                LAS unsigned char* ost = lds + 2 * BUF + (32 * wid) * OSTP;
#pragma unroll
                for (int dt = 0; dt < 4; ++dt)
#pragma unroll
                    for (int a = 0; a < 4; ++a) { u32x2 w; w.x = pg8::cvt_pk_bf16(o[dt][4 * a] * linv, o[dt][4 * a + 1] * linv); w.y = pg8::cvt_pk_bf16(o[dt][4 * a + 2] * linv, o[dt][4 * a + 3] * linv);
                        *(LAS u32x2*)(ost + r32 * OSTP + (32 * dt + 8 * a + 4 * hi) * 2) = w; }
                asm volatile("s_waitcnt lgkmcnt(0)" ::: "memory");
                bf16_t* orow = MQ + (size_t)(b * SEQ + tb * 256 + 32 * wid) * 1024 + h * 256 + 128 * ph;
#pragma unroll
                for (int i = 0; i < 8; ++i) { const int pc = lane + 64 * i, row = pc >> 4, c16 = pc & 15;
                    const u32x4 w = *(LAS const u32x4*)(ost + row * OSTP + c16 * 16);
                    *(u32x4*)(orow + (size_t)row * 1024 + c16 * 8) = w; }
                asm volatile("s_waitcnt lgkmcnt(0)" ::: "memory");
            }
        }
    }
#undef MEM_LDK
#undef MEM_STK
#undef MEM_LDV
#undef MEM_STV
}
namespace nsa2 {
typedef short bf16x8 __attribute__((ext_vector_type(8)));
typedef short s16x4 __attribute__((ext_vector_type(4)));
typedef short v4i16_t __attribute__((ext_vector_type(4)));
typedef float f32x16 __attribute__((ext_vector_type(16)));
typedef LAS const unsigned char* lptr;
constexpr int IP = 136;
constexpr int L_K = 0, L_V = 16384, L_IA = 32768, L_IB = L_IA + 64 * IP * 4, L_CTR = L_IB + 64 * IP * 4, L_Q = L_CTR + 256;
constexpr float C2 = 0.125f * 1.4426950408889634f;
__device__ __forceinline__ int crow(int r, int hi) { return (r & 3) + 8 * (r >> 2) + 4 * hi; }
__device__ __forceinline__ s16x4 vtr(lptr p) { return __builtin_bit_cast(s16x4, __builtin_amdgcn_ds_read_tr16_b64_v4i16((LAS v4i16_t*)p)); }
__device__ __forceinline__ int tile_koff(int pitch, int wid, int lane) { return lane * pitch + wid * 8; }
__device__ __forceinline__ int tile_voff(int pitch, int wid, int lane) { return (16 * (wid & 3) + (lane >> 2)) * pitch + (wid >> 2) * 32 + (lane & 3) * 8; }
__device__ __forceinline__ void tile_load(u32x4& kr, u32x4& vr, const bf16_t* kb, const bf16_t* vb, int koff, int voff) {
    kr = *(const u32x4*)(kb + koff);
    vr = *(const u32x4*)(vb + voff);
}
__device__ __forceinline__ void tile_store(LAS unsigned char* lds, int slot, const u32x4& kr, const u32x4& vr, int wid, int lane) {
    *(LAS u32x4*)(lds + L_K + slot * 8192 + wid * 1024 + lane * 16) = kr;
    *(LAS u32x4*)(lds + L_V + slot * 8192 + wid * 1024 + lane * 16) = vr;
}
__device__ __forceinline__ void qkt(f32x16& p0, f32x16& p1, lptr Kslot, lptr qr, int r32, int hi, float init = 0.f) {
    lptr kb = Kslot + hi * 1024 + r32 * 16;
#pragma unroll
    for (int r = 0; r < 16; ++r) { p0[r] = init; p1[r] = init; }
    bf16x8 b0[4], b1[4], qf[4];
#pragma unroll
    for (int d0 = 0; d0 < 4; ++d0) { b0[d0] = *(LAS const bf16x8*)(kb + d0 * 2048); b1[d0] = *(LAS const bf16x8*)(kb + d0 * 2048 + 512); qf[d0] = *(LAS const bf16x8*)(qr + d0 * 8192); }
#pragma unroll
    for (int d0 = 0; d0 < 4; ++d0) {
        p0 = __builtin_amdgcn_mfma_f32_32x32x16_bf16(b0[d0], qf[d0], p0, 0, 0, 0);
        p1 = __builtin_amdgcn_mfma_f32_32x32x16_bf16(b1[d0], qf[d0], p1, 0, 0, 0);
    }
    __builtin_amdgcn_sched_group_barrier(0x100, 9, 0);
    __builtin_amdgcn_sched_group_barrier(0x008, 2, 0);
    __builtin_amdgcn_sched_group_barrier(0x100, 3, 0);
    __builtin_amdgcn_sched_group_barrier(0x008, 6, 0);
}
__device__ __forceinline__ unsigned pk(float lo, float hi) { return pg8::cvt_pk_bf16(lo, hi); }
__device__ __forceinline__ int group8_sum(int v) {
    v += __builtin_amdgcn_mov_dpp(v, 0xB1, 0xF, 0xF, true);
    v += __builtin_amdgcn_mov_dpp(v, 0x4E, 0xF, 0xF, true);
    v += __builtin_amdgcn_mov_dpp(v, 0x141, 0xF, 0xF, true);
    return v;
}
__device__ __forceinline__ float quad_sum(float v) {
    v += __builtin_bit_cast(float, __builtin_amdgcn_mov_dpp(__builtin_bit_cast(int, v), 0xB1, 0xF, 0xF, true));
    v += __builtin_bit_cast(float, __builtin_amdgcn_mov_dpp(__builtin_bit_cast(int, v), 0x4E, 0xF, 0xF, true));
    return v;
}
__device__ __forceinline__ void pvt(f32x16 (&o)[2], lptr Vslot, const f32x16& p0, const f32x16& p1, int lane, int hi) {
    lptr vp = Vslot + ((lane >> 4) & 1) * 32 + (lane & 3) * 8 + (4 * hi + ((lane & 15) >> 2)) * 64;
    u32x4 w0, w1, w2, w3;
    w0.x = pk(p0[0], p0[1]); w0.y = pk(p0[2], p0[3]); w0.z = pk(p0[4], p0[5]); w0.w = pk(p0[6], p0[7]);
    w1.x = pk(p0[8], p0[9]); w1.y = pk(p0[10], p0[11]); w1.z = pk(p0[12], p0[13]); w1.w = pk(p0[14], p0[15]);
    w2.x = pk(p1[0], p1[1]); w2.y = pk(p1[2], p1[3]); w2.z = pk(p1[4], p1[5]); w2.w = pk(p1[6], p1[7]);
    w3.x = pk(p1[8], p1[9]); w3.y = pk(p1[10], p1[11]); w3.z = pk(p1[12], p1[13]); w3.w = pk(p1[14], p1[15]);
    const bf16x8 pw0 = __builtin_bit_cast(bf16x8, w0), pw1 = __builtin_bit_cast(bf16x8, w1), pw2 = __builtin_bit_cast(bf16x8, w2), pw3 = __builtin_bit_cast(bf16x8, w3);
    s16x4 lo[2][4], hh[2][4];
#pragma unroll
    for (int ks = 0; ks < 4; ++ks)
#pragma unroll
        for (int d0 = 0; d0 < 2; ++d0) { lo[d0][ks] = vtr(vp + d0 * 4096 + ks * 1024); hh[d0][ks] = vtr(vp + d0 * 4096 + ks * 1024 + 512); }
#define NSA_VF(d, k) (bf16x8){lo[d][k][0], lo[d][k][1], lo[d][k][2], lo[d][k][3], hh[d][k][0], hh[d][k][1], hh[d][k][2], hh[d][k][3]}
    o[0] = __builtin_amdgcn_mfma_f32_32x32x16_bf16(NSA_VF(0, 0), pw0, o[0], 0, 0, 0); o[1] = __builtin_amdgcn_mfma_f32_32x32x16_bf16(NSA_VF(1, 0), pw0, o[1], 0, 0, 0);
    o[0] = __builtin_amdgcn_mfma_f32_32x32x16_bf16(NSA_VF(0, 1), pw1, o[0], 0, 0, 0); o[1] = __builtin_amdgcn_mfma_f32_32x32x16_bf16(NSA_VF(1, 1), pw1, o[1], 0, 0, 0);
    o[0] = __builtin_amdgcn_mfma_f32_32x32x16_bf16(NSA_VF(0, 2), pw2, o[0], 0, 0, 0); o[1] = __builtin_amdgcn_mfma_f32_32x32x16_bf16(NSA_VF(1, 2), pw2, o[1], 0, 0, 0);
    o[0] = __builtin_amdgcn_mfma_f32_32x32x16_bf16(NSA_VF(0, 3), pw3, o[0], 0, 0, 0); o[1] = __builtin_amdgcn_mfma_f32_32x32x16_bf16(NSA_VF(1, 3), pw3, o[1], 0, 0, 0);
#undef NSA_VF
    __builtin_amdgcn_sched_group_barrier(0x100, 8, 1);
    __builtin_amdgcn_sched_group_barrier(0x008, 4, 1);
    __builtin_amdgcn_sched_group_barrier(0x100, 8, 1);
    __builtin_amdgcn_sched_group_barrier(0x008, 4, 1);
}
__device__ __forceinline__ float tile_max(const f32x16& p0, const f32x16& p1) {
    float a = fmaxf(p0[0], p1[0]);
#pragma unroll
    for (int r = 1; r < 16; ++r) a = fmaxf(a, fmaxf(p0[r], p1[r]));
    return fmaxf(a, __shfl_xor(a, 32));
}
__device__ __forceinline__ void osm_step(f32x16& p0, f32x16& p1, float& m, float& l, f32x16 (&o)[2], lptr Vslot, int lane, int hi) {
    const float mx = tile_max(p0, p1);
    const float mn = fmaxf(m, mx), mu = (mn == -INFINITY) ? 0.f : mn;
    const float alpha = __builtin_amdgcn_exp2f(m - mu);
    float ls = 0.f;
#pragma unroll
    for (int r = 0; r < 16; ++r) { p0[r] = __builtin_amdgcn_exp2f(p0[r] - mu); p1[r] = __builtin_amdgcn_exp2f(p1[r] - mu); ls += p0[r] + p1[r]; }
    l = l * alpha + ls; m = mn;
#pragma unroll
    for (int r = 0; r < 16; ++r) { o[0][r] *= alpha; o[1][r] *= alpha; }
    pvt(o, Vslot, p0, p1, lane, hi);
}
template <int MODE>
__device__ __forceinline__ void fast_first(u32x4& pk0, u32x4& pv0, u32x4& pk1, const bf16_t* kb, const bf16_t* vb, int kofs, int vofs, int blk) {
    const int jlo = (MODE == 1) ? max(0, blk - 8) : 0, nt = (MODE == 1) ? (blk - jlo + 1) : (blk + 1);
    const int j0 = (MODE == 1) ? blk : 0, j1 = (nt > 1) ? ((MODE == 1) ? jlo : 1) : j0;
    const __amdgpu_buffer_rsrc_t rk = __builtin_amdgcn_make_buffer_rsrc((void*)kb, (short)0, SEQ * 1536 * 2, 0x00020000), rv = __builtin_amdgcn_make_buffer_rsrc((void*)vb, (short)0, SEQ * 1536 * 2, 0x00020000);
    pk0 = __builtin_bit_cast(u32x4, __builtin_amdgcn_raw_buffer_load_b128(rk, (unsigned)kofs * 2u, (unsigned)j0 * (64u * 1536u * 2u), 0));
    pv0 = __builtin_bit_cast(u32x4, __builtin_amdgcn_raw_buffer_load_b128(rv, (unsigned)vofs * 2u, (unsigned)j0 * (64u * 1536u * 2u), 0));
    pk1 = __builtin_bit_cast(u32x4, __builtin_amdgcn_raw_buffer_load_b128(rk, (unsigned)kofs * 2u, (unsigned)j1 * (64u * 1536u * 2u), 0));
}
template <int MODE>
__device__ __forceinline__ void fast_loop(LAS unsigned char* lds, const bf16_t* kb, const bf16_t* vb, int kofs, int vofs, int blk, int tl, int t, unsigned long long mylo, unsigned long long myhi,
                                          float Bnd, lptr qr, f32x16 (&oacc)[2], float& l, int wid, int lane, int r32, int hi, u32x4 pk0, u32x4 pv0, u32x4 pk1) {
    const int jlo = (MODE == 1) ? max(0, blk - 8) : 0, nt = (MODE == 1) ? (blk - jlo + 1) : (blk + 1);
    auto tile_of = [&](int i) -> int { return (MODE == 1) ? ((i == 0) ? blk : jlo + i - 1) : i; };
    auto sel_of = [&](int j) -> bool { return (MODE == 1) ? true : ((j < 64) ? (((mylo >> j) & 1ull) != 0ull) : (((myhi >> (j - 64)) & 1ull) != 0ull)); };
    u32x4 krA, vrA, krB, vrB;
    const unsigned kofb = (unsigned)kofs * 2u, vofb = (unsigned)vofs * 2u;
    const __amdgpu_buffer_rsrc_t rk = __builtin_amdgcn_make_buffer_rsrc((void*)kb, (short)0, SEQ * 1536 * 2, 0x00020000), rv = __builtin_amdgcn_make_buffer_rsrc((void*)vb, (short)0, SEQ * 1536 * 2, 0x00020000);
    {
        const int j1 = tile_of(min(1, nt - 1)), j2 = tile_of(min(2, nt - 1));
        *(LAS u32x4*)(lds + L_K + wid * 1024 + lane * 16) = pk0; *(LAS u32x4*)(lds + L_V + wid * 1024 + lane * 16) = pv0;
        *(LAS u32x4*)(lds + L_K + 8192 + wid * 1024 + lane * 16) = pk1;
        krB = __builtin_bit_cast(u32x4, __builtin_amdgcn_raw_buffer_load_b128(rk, kofb, (unsigned)j2 * (64u * 1536u * 2u), 0));
        vrB = __builtin_bit_cast(u32x4, __builtin_amdgcn_raw_buffer_load_b128(rv, vofb, (unsigned)j1 * (64u * 1536u * 2u), 0));
    }
    __syncthreads();
    f32x16 sa0, sa1, sb0, sb1;
    {
        const bool s0 = sel_of(tile_of(0));
        if (__any(s0)) qkt(sa0, sa1, (lptr)lds + L_K, qr, r32, hi, s0 ? -Bnd : -INFINITY);
    }
    __syncthreads();
    auto step = [&](int i, f32x16& c0, f32x16& c1, f32x16& n0, f32x16& n1, u32x4& krL, u32x4& vrL, const u32x4& krS, const u32x4& vrS) {
        const int j = tile_of(i);
        krL = __builtin_bit_cast(u32x4, __builtin_amdgcn_raw_buffer_load_b128(rk, kofb, (unsigned)tile_of(min(i + 3, nt - 1)) * (64u * 1536u * 2u), 0));
        vrL = __builtin_bit_cast(u32x4, __builtin_amdgcn_raw_buffer_load_b128(rv, vofb, (unsigned)tile_of(min(i + 2, nt - 1)) * (64u * 1536u * 2u), 0));
        if (i + 1 < nt) { const bool sn = sel_of(tile_of(i + 1)); if (__any(sn)) qkt(n0, n1, (lptr)lds + L_K + ((i + 1) & 1) * 8192, qr, r32, hi, sn ? -Bnd : -INFINITY); }
        if (__any(sel_of(j))) {
            bool masked; int klo, khi;
            if (MODE == 0) { masked = (j == blk); klo = -64; khi = tl - 4 * hi; }
            else { masked = (j == blk) || (j == blk - 8); klo = t - 511 - 64 * j - 4 * hi; khi = t - 64 * j - 4 * hi; }
            if (masked) {
#pragma unroll
                for (int r = 0; r < 16; ++r) { const int kk = crow(r, 0); c0[r] = (kk >= klo && kk <= khi) ? __builtin_amdgcn_exp2f(c0[r]) : 0.f; c1[r] = (kk + 32 >= klo && kk + 32 <= khi) ? __builtin_amdgcn_exp2f(c1[r]) : 0.f; }
            } else {
#pragma unroll
                for (int r = 0; r < 16; ++r) { c0[r] = __builtin_amdgcn_exp2f(c0[r]); c1[r] = __builtin_amdgcn_exp2f(c1[r]); }
            }
            float ls = 0.f;
#pragma unroll
            for (int r = 0; r < 16; ++r) ls += c0[r] + c1[r];
            l += ls;
            pvt(oacc, (lptr)lds + L_V + (i & 1) * 8192, c0, c1, lane, hi);
        }
        *(LAS u32x4*)(lds + L_K + (i & 1) * 8192 + wid * 1024 + lane * 16) = krS;
        *(LAS u32x4*)(lds + L_V + ((i + 1) & 1) * 8192 + wid * 1024 + lane * 16) = vrS;
        __syncthreads();
    };
    for (int i = 0; i < nt; i += 2) {
        step(i, sa0, sa1, sb0, sb1, krA, vrA, krB, vrB);
        if (i + 1 < nt) step(i + 1, sb0, sb1, sa0, sa1, krB, vrB, krA, vrA);
    }
}
}

__device__ __forceinline__ void phase_nsa_mfma(const Params& p, LAS unsigned char* lds, int bid, int nb) {
    using namespace nsa2;
    int tid_ = threadIdx.x; asm volatile("" : "+v"(tid_));
    const int tid = tid_, lane = tid & 63, wid = __builtin_amdgcn_readfirstlane(tid >> 6), r32 = lane & 31, hi = lane >> 5;
    bf16_t* NQ = (bf16_t*)(p.ws + WS_NQ); const bf16_t* NKV = (const bf16_t*)(p.ws + WS_NKV);
    const bf16_t* KC = (const bf16_t*)(p.ws + WS_KC); const bf16_t* VC = (const bf16_t*)(p.ws + WS_VC); const float* SM = (const float*)(p.ws + WS_SM);
    LAS float* IA = (LAS float*)(lds + L_IA); LAS float* IB = (LAS float*)(lds + L_IB);
    const float gq = wave_max(fabsf(p.nsa_q_norm[lane])), gks = wave_max(fabsf(p.nsa_k_norm[64 + lane])), gkw = wave_max(fabsf(p.nsa_k_norm[128 + lane]));
    const float Bs = 11.54156f * 1.02f * gq * gks, Bw = 11.54156f * 1.02f * gq * gkw;
    const bool fast = __builtin_amdgcn_readfirstlane((int)((Bs < 60.f) && (Bw < 60.f))) != 0;
    unsigned* ctr = (unsigned*)(p.ws + 16384);
    int e_next = 0;
    if (tid == 0) e_next = (int)atomicAdd(ctr, 1u);
    for (;;) {
        __syncthreads();
        if (threadIdx.x == 0) *(LAS int*)(lds + L_CTR) = e_next;
        __syncthreads();
        const int e = *(LAS const int*)(lds + L_CTR);
        if (e >= 1024) break;
        const int blk = 127 - (e >> 3), bh = e & 7, b = bh >> 2, h = bh & 3;
        int tid_i = tid_; asm volatile("" : "+v"(tid_i));
        const int tid = tid_i, lane = tid & 63, r32 = lane & 31, hi = lane >> 5;
        const int t0 = blk * 64, tl = 8 * wid + (r32 >> 2), g = r32 & 3, t = t0 + tl;
        const int tg = b * SEQ + t;
        const int qoff = tg * 1024 + (4 * h + g) * 64;
        const lptr qr = (lptr)lds + L_Q + tid * 16;
        const int goff = tg * 64 + 16 + (4 * h + g) * 3;
        f32x16 ot[2];
        u32x4 kr, vr;
        const int kofc = tile_koff(64, wid, lane), vofc = tile_voff(64, wid, lane), kofs = tile_koff(1536, wid, lane), vofs = tile_voff(1536, wid, lane);
        const bf16_t* kcb = KC + (size_t)(b * 4 + h) * 512 * 64; const bf16_t* vcb = VC + (size_t)(b * 4 + h) * 512 * 64;
        const int nvmax = min(NCMP, 4 * blk + 3), ntc = (nvmax + 63) >> 6;
        const int nvq = (t >= 31) ? min(NCMP, (t - 31) / 16 + 1) : 0;
        float m = -INFINITY, l = 0.f;
        const __amdgpu_buffer_rsrc_t rkc = __builtin_amdgcn_make_buffer_rsrc((void*)kcb, (short)0, 512 * 64 * 2, 0x00020000), rvc = __builtin_amdgcn_make_buffer_rsrc((void*)vcb, (short)0, 512 * 64 * 2, 0x00020000);
        {
            bf16x8 qv[4];
#pragma unroll
            for (int d0 = 0; d0 < 4; ++d0) qv[d0] = *(const bf16x8*)(NQ + qoff + 16 * d0 + 8 * hi);
            tile_load(kr, vr, kcb, vcb, kofc, vofc);
#pragma unroll
            for (int d0 = 0; d0 < 4; ++d0) *(LAS bf16x8*)(lds + L_Q + d0 * 8192 + tid * 16) = qv[d0];
            tile_store(lds, 0, kr, vr, wid, lane);
        }
        const float graw0 = SM[goff], graw1 = SM[goff + 1], graw2 = SM[goff + 2];
        __syncthreads();
        for (int i = 0; i < ntc; ++i) {
            { const int inx = (i + 1 < ntc) ? i + 1 : 0;
              kr = __builtin_bit_cast(u32x4, __builtin_amdgcn_raw_buffer_load_b128(rkc, (unsigned)kofc * 2u, (unsigned)inx * 8192u, 0));
              vr = __builtin_bit_cast(u32x4, __builtin_amdgcn_raw_buffer_load_b128(rvc, (unsigned)vofc * 2u, (unsigned)inx * 8192u, 0)); }
            f32x16 p0, p1; qkt(p0, p1, (lptr)lds + L_K + (i & 1) * 8192, qr, r32, hi);
            const int n0 = 64 * i;
            const int nl = nvq - n0 - 4 * hi;
#pragma unroll
            for (int r = 0; r < 16; ++r) { p0[r] = (crow(r, 0) < nl) ? p0[r] : -INFINITY; p1[r] = (crow(r, 0) + 32 < nl) ? p1[r] : -INFINITY; }
            const float mx = tile_max(p0, p1), mn = fmaxf(m, mx), mu = (mn == -INFINITY) ? 0.f : mn;
            float ls = 0.f;
#pragma unroll
            for (int r = 0; r < 16; ++r) ls += __builtin_amdgcn_exp2f(p0[r] - mu) + __builtin_amdgcn_exp2f(p1[r] - mu);
            l = l * __builtin_amdgcn_exp2f(m - mu) + ls; m = mn;
            tile_store(lds, (i + 1) & 1, kr, vr, wid, lane);
            __syncthreads();
        }
        {
            const float lt = l + __shfl_xor(l, 32), linv = lt > 0.f ? 1.f / lt : 0.f, mu = (m == -INFINITY) ? 0.f : m;
            const float gate_c = sigmoidf_(graw0);
            f32x16 oc[2];
#pragma unroll
            for (int r = 0; r < 16; ++r) { oc[0][r] = 0.f; oc[1][r] = 0.f; }
            for (int i = 0; i < ntc; ++i) {
                const int sl = (ntc + i) & 1;
                { const int inx = (i + 1 < ntc) ? i + 1 : i;
                  kr = __builtin_bit_cast(u32x4, __builtin_amdgcn_raw_buffer_load_b128(rkc, (unsigned)kofc * 2u, (unsigned)inx * 8192u, 0));
                  vr = __builtin_bit_cast(u32x4, __builtin_amdgcn_raw_buffer_load_b128(rvc, (unsigned)vofc * 2u, (unsigned)inx * 8192u, 0)); }
                f32x16 p0, p1; qkt(p0, p1, (lptr)lds + L_K + sl * 8192, qr, r32, hi);
                const int n0 = 64 * i, nl = nvq - n0 - 4 * hi;
#pragma unroll
                for (int r = 0; r < 16; ++r) {
                    p0[r] = (crow(r, 0) < nl) ? __builtin_amdgcn_exp2f(p0[r] - mu) * linv : 0.f; p1[r] = (crow(r, 0) + 32 < nl) ? __builtin_amdgcn_exp2f(p1[r] - mu) * linv : 0.f; }
#pragma unroll
                for (int a = 0; a < 4; ++a) {
                    float A0 = p0[4 * a] + p0[4 * a + 1] + p0[4 * a + 2] + 0.5f * p0[4 * a + 3], B0 = 0.5f * p0[4 * a + 3];
                    float A1 = p1[4 * a] + p1[4 * a + 1] + p1[4 * a + 2] + 0.5f * p1[4 * a + 3], B1 = 0.5f * p1[4 * a + 3];
                    A0 = quad_sum(A0); B0 = quad_sum(B0); A1 = quad_sum(A1); B1 = quad_sum(B1);
                    const int s = (n0 >> 2) + 2 * a + hi;
                    if (g == 0) { IA[tl * IP + s] = A0; IB[tl * IP + s] = B0; IA[tl * IP + s + 8] = A1; IB[tl * IP + s + 8] = B1; }
                }
                pvt(oc, (lptr)lds + L_V + sl * 8192, p0, p1, lane, hi);
                if (i + 1 < ntc) tile_store(lds, sl ^ 1, kr, vr, wid, lane);
                __syncthreads();
            }
#pragma unroll
            for (int r = 0; r < 16; ++r) { ot[0][r] = gate_c * oc[0][r]; ot[1][r] = gate_c * oc[1][r]; }
        }
        const bf16_t* kbs = NKV + (size_t)b * SEQ * 1536 + 2 * 256 + h * 64;
        u32x4 pk0, pv0, pk1;
        fast_first<0>(pk0, pv0, pk1, kbs, kbs + 256, kofs, vofs, blk);
        unsigned long long mylo = 0ull, myhi = 0ull;
        {
            unsigned long long flo = 1ull, fhi = 0ull; int nforced = 1;
            if (blk >= 2) { const int s = blk - 1; if (s < 64) flo |= 1ull << s; else fhi |= 1ull << (s - 64); ++nforced; }
            if (blk >= 1) { const int s = blk; if (s < 64) flo |= 1ull << s; else fhi |= 1ull << (s - 64); ++nforced; }
            const int need = 16 - nforced, ncand = blk - 2;
            mylo = flo; myhi = fhi;
            if (ncand > 0) {
                const int k8 = lane >> 3, s8 = lane & 7, tk = 8 * wid + k8;
                unsigned u[16]; unsigned vbits = 0u;
#pragma unroll
                for (int j = 0; j < 16; ++j) { const int c = s8 + 8 * j; const bool v = (c >= 1) && (c <= blk - 2);
                    const float a = IA[tk * IP + c], b2 = IB[tk * IP + (c >= 1 ? c - 1 : 0)];
                    u[j] = v ? __float_as_uint(a + b2) : 0u; vbits |= (v ? 1u : 0u) << j; }
                unsigned selbits;
                if (ncand <= need) selbits = vbits;
                else {
                    unsigned T = 0u; bool done = false;
                    for (int bit = 30; bit >= 0; --bit) {
                        const unsigned cc = T | (1u << bit);
                        int cnt = 0;
#pragma unroll
                        for (int j = 0; j < 16; ++j) cnt += (u[j] >= cc) ? 1 : 0;
                        cnt = group8_sum(cnt);
                        if (!done) { if (cnt >= need) T = cc; if (cnt == need) { done = true; T = cc - 1u; } }
                        if (__all(done)) break;
                    }
                    int gt = 0; selbits = 0u;
#pragma unroll
                    for (int j = 0; j < 16; ++j) { const bool g1 = u[j] > T; gt += g1 ? 1 : 0; selbits |= (g1 ? 1u : 0u) << j; }
                    const int rem = need - group8_sum(gt);
                    if (__any(rem > 0)) {
                        int run = 0;
#pragma unroll
                        for (int j = 0; j < 16; ++j) { const bool eq = ((vbits >> j) & 1u) && (u[j] == T);
                            const unsigned long long bq = __ballot(eq);
                            const unsigned grp = (unsigned)(bq >> (8 * k8)) & 0xffu;
                            if (eq && (run + __popc(grp & ((1u << s8) - 1u)) < rem)) selbits |= 1u << j;
                            run += __popc(grp); }
                    }
                }
#pragma unroll
                for (int j = 0; j < 16; ++j) { const unsigned long long bs = __ballot(((selbits >> j) & 1u) != 0u);
                    const unsigned long long byte = (bs >> (8 * (r32 >> 2))) & 0xffull;
                    if (j < 8) mylo |= byte << (8 * j); else myhi |= byte << (8 * (j - 8)); }
            }
        }
        __syncthreads();
        LAS float* OT = (LAS float*)(lds + L_IA);
#pragma unroll
        for (int r = 0; r < 16; ++r) { OT[r * 512 + tid] = ot[0][r]; OT[(16 + r) * 512 + tid] = ot[1][r]; }
        {
            const bf16_t* kb = NKV + (size_t)b * SEQ * 1536 + 2 * 256 + h * 64; const bf16_t* vb = kb + 256;
            f32x16 os[2];
#pragma unroll
            for (int r = 0; r < 16; ++r) { os[0][r] = 0.f; os[1][r] = 0.f; }
            m = -INFINITY; l = 0.f;
            if (fast) fast_loop<0>(lds, kb, vb, kofs, vofs, blk, tl, t, mylo, myhi, Bs, qr, os, l, wid, lane, r32, hi, pk0, pv0, pk1);
            else {
            tile_load(kr, vr, kb, vb, kofs, vofs); tile_store(lds, 0, kr, vr, wid, lane);
            __syncthreads();
            for (int j = 0; j <= blk; ++j) {
                if (j < blk) tile_load(kr, vr, kb + (size_t)(j + 1) * 64 * 1536, vb + (size_t)(j + 1) * 64 * 1536, kofs, vofs);
                const bool sel = (j < 64) ? ((mylo >> j) & 1ull) : ((myhi >> (j - 64)) & 1ull);
                if (__any(sel)) {
                    f32x16 p0, p1;
                    {
                        qkt(p0, p1, (lptr)lds + L_K + (j & 1) * 8192, qr, r32, hi);
                        const int lim = (sel ? ((j == blk) ? tl : 63) : -1) - 4 * hi;
#pragma unroll
                        for (int r = 0; r < 16; ++r) { p0[r] = (crow(r, 0) <= lim) ? p0[r] : -INFINITY; p1[r] = (crow(r, 0) + 32 <= lim) ? p1[r] : -INFINITY; }
                        osm_step(p0, p1, m, l, os, (lptr)lds + L_V + (j & 1) * 8192, lane, hi);
                    }
                }
                if (j < blk) tile_store(lds, (j + 1) & 1, kr, vr, wid, lane);
                __syncthreads();
            }
            }
            fast_first<1>(pk0, pv0, pk1, kbs + 512, kbs + 768, kofs, vofs, blk);
            const float lt = l + __shfl_xor(l, 32), sc = sigmoidf_(graw1) * (lt > 0.f ? 1.f / lt : 0.f);
#pragma unroll
            for (int r = 0; r < 16; ++r) { OT[r * 512 + tid] += sc * os[0][r]; OT[(16 + r) * 512 + tid] += sc * os[1][r]; }
        }
        {
            const bf16_t* kb = NKV + (size_t)b * SEQ * 1536 + 4 * 256 + h * 64; const bf16_t* vb = kb + 256;
            f32x16 ow[2];
#pragma unroll
            for (int r = 0; r < 16; ++r) { ow[0][r] = 0.f; ow[1][r] = 0.f; }
            m = -INFINITY; l = 0.f;
            const int jlo = max(0, blk - 8), nt = blk - jlo + 1;
            if (fast) fast_loop<1>(lds, kb, vb, kofs, vofs, blk, tl, t, mylo, myhi, Bw, qr, ow, l, wid, lane, r32, hi, pk0, pv0, pk1);
            else {
            tile_load(kr, vr, kb + (size_t)blk * 64 * 1536, vb + (size_t)blk * 64 * 1536, kofs, vofs); tile_store(lds, 0, kr, vr, wid, lane);
            __syncthreads();
            for (int i = 0; i < nt; ++i) {
                const int j = (i == 0) ? blk : jlo + i - 1;
                if (i + 1 < nt) { const int jn = jlo + i; tile_load(kr, vr, kb + (size_t)jn * 64 * 1536, vb + (size_t)jn * 64 * 1536, kofs, vofs); }
                f32x16 p0, p1;
                const int klo = t - 511 - 64 * j - 4 * hi, khi = t - 64 * j - 4 * hi;
                {
                    qkt(p0, p1, (lptr)lds + L_K + (i & 1) * 8192, qr, r32, hi);
#pragma unroll
                    for (int r = 0; r < 16; ++r) { const int kk = crow(r, 0); p0[r] = (kk >= klo && kk <= khi) ? p0[r] : -INFINITY; p1[r] = (kk + 32 >= klo && kk + 32 <= khi) ? p1[r] : -INFINITY; }
                    osm_step(p0, p1, m, l, ow, (lptr)lds + L_V + (i & 1) * 8192, lane, hi);
                }
                if (i + 1 < nt) tile_store(lds, (i + 1) & 1, kr, vr, wid, lane);
                __syncthreads();
            }
            }
            const float lt = l + __shfl_xor(l, 32), sc = sigmoidf_(graw2) * (lt > 0.f ? 1.f / lt : 0.f);
#pragma unroll
            for (int r = 0; r < 16; ++r) { ot[0][r] = OT[r * 512 + tid] + sc * ow[0][r]; ot[1][r] = OT[(16 + r) * 512 + tid] + sc * ow[1][r]; }
        }
        if (threadIdx.x == 0) e_next = (int)atomicAdd(ctr, 1u);
        {
            LAS unsigned char* ost = lds + L_K + wid * 4096;
            const int k8 = r32 >> 2;
#pragma unroll
            for (int d0 = 0; d0 < 2; ++d0)
#pragma unroll
                for (int a = 0; a < 4; ++a) { u32x2 w; w.x = pk(ot[d0][4 * a], ot[d0][4 * a + 1]); w.y = pk(ot[d0][4 * a + 2], ot[d0][4 * a + 3]);
                    *(LAS u32x2*)(ost + k8 * 512 + ((g * 128 + 64 * d0 + 16 * a + 8 * hi) ^ (k8 << 4))) = w; }
            asm volatile("s_waitcnt lgkmcnt(0)" ::: "memory");
            bf16_t* orow = NQ + (size_t)(b * SEQ + t0 + 8 * wid) * 1024 + 4 * h * 64;
#pragma unroll
            for (int i = 0; i < 4; ++i) { const int pi = lane + 64 * i, rk = pi >> 5, j = pi & 31;
                const u32x4 w = *(LAS const u32x4*)(ost + rk * 512 + ((16 * j) ^ (rk << 4)));
                *(u32x4*)(orow + (size_t)rk * 1024 + j * 8) = w; }
            asm volatile("s_waitcnt lgkmcnt(0)" ::: "memory");
        }
    }
}

__device__ __forceinline__ Params kparams() {
#if defined(__HIP_DEVICE_COMPILE__)
    auto k = __builtin_amdgcn_kernarg_segment_ptr();
    asm volatile("" : "+s"(k));
    return *(const Params __attribute__((address_space(4)))*)k;
#else
    return Params{};
#endif
}
__global__ void __launch_bounds__(NTHREADS, 2) mega(Params p_unused) {
    cg::grid_group grid = cg::this_grid();
    extern __shared__ __attribute__((aligned(16))) unsigned char lds[];
    float* sm = (float*)lds;
    LAS unsigned char* lds3 = (LAS unsigned char*)lds;
    const int bid = blockIdx.x, nb = gridDim.x;
    volatile LAS unsigned* xst = (volatile LAS unsigned*)(lds3 + LDS_BYTES - 16);
    if (threadIdx.x < 4) xst[threadIdx.x] = 0u;
    __syncthreads();
    { const Params p = kparams(); (void)xcd_barrier_post((unsigned*)p.ws, xst); }
#define GRID_BAR() do { const Params pb_ = kparams(); XcdBarrier xb_; xb_.bar = (unsigned*)pb_.ws; xb_.x = xb_xcc_id(); xb_.st = (volatile LAS unsigned*)(lds3 + LDS_BYTES - 16); xcd_barrier(xb_); } while (0)
    { const Params p = kparams();
      phase_prep(p, bid, nb);
      phase_convert(p, sm, bid, nb); }
    grid.sync();
    {
        const Params p = kparams(); const char* BT = (const char*)(p.ws + WS_BT);
        pg8::Gemm g{1024}; SchedEarly S{(const char*)p.out, BT, nb, bid}; EpiEarly E{p.ws, lds3, (bf16_t*)((unsigned char*)p.out + OUT_UV), p.nsa_q_norm, p.nsa_k_norm, p.pe_k, p.pe_v, p.mem_q_norm, p.mem_k_norm};
        pg8::gemm_phase<EpiEarly, SchedEarly, true, true>(lds3, g, S, E);
    }
    GRID_BAR();
    if (bid < 32) {
        const Params p = kparams();
        pg8::Gemm g{2048}; SchedCmp S{(const char*)(p.ws + WS_UK), (const char*)p.out + OUT_UV, (const char*)(p.ws + WS_BTC), bid}; EpiCmp E{(bf16_t*)(p.ws + WS_H1)};
        pg8::gemm_phase<EpiCmp, SchedCmp, true, true>(lds3, g, S, E);
        __syncthreads();
        compress_stage2(p, bid);
    }
    {
        const Params p = kparams();
        unsigned* ctr2 = (unsigned*)(p.ws + 16384 + 1024);
        phase_memattn_lds(p, lds3, ctr2);
        phase_gla_prepass(p, sm, ctr2 + 64);
    }
    GRID_BAR();
    if (bid < 32) { const Params p = kparams(); gla_main(p, lds3, bid); }
    { const Params p = kparams(); phase_nsa_mfma(p, lds3, bid, nb); }
    GRID_BAR();
    {
        const Params p = kparams(); const char* BT = (const char*)(p.ws + WS_BT);
        pg8::Gemm g{1024}; SchedPlain S{(const char*)p.out, BT + (size_t)R_G * 2048, 12, 768, nb, bid}; EpiGates E{p.ws};
        pg8::gemm_phase<EpiGates, SchedPlain, true, true>(lds3, g, S, E);
    }
    GRID_BAR();
    {
        const Params p = kparams(); const char* BT = (const char*)(p.ws + WS_BT);
        pg8::Gemm g{1024};
        SchedMix S{(const char*)p.out, (const char*)(p.ws + WS_GV), (const char*)(p.ws + WS_NQ), (const char*)(p.ws + WS_MQ), BT + (size_t)R_M * 2048, BT + (size_t)R_B * 2048, nb, bid};
        EpiMix E{p.ws};
        pg8::gemm_phase<EpiMix, SchedMix, true, true>(lds3, g, S, E);
    }
    GRID_BAR();
    {
        const Params p = kparams(); const char* BT = (const char*)(p.ws + WS_BT);
        pg8::Gemm g{1024}; SchedPlain S{(const char*)(p.ws + WS_GQK), BT + (size_t)R_O * 2048, 4, 256, nb, bid}; EpiOut E{p.x, p.out};
        pg8::gemm_phase<EpiOut, SchedPlain, true, true>(lds3, g, S, E);
    }
}
#undef GRID_BAR

extern "C" void kernel_launch(void* const* d_in, const int* in_sizes, int n_in, void* d_out, int out_size, void* d_ws, size_t ws_size, hipStream_t stream) {
    static int grid_blocks = 0;
    if (grid_blocks == 0) {
        if (n_in != 22 || in_sizes[0] != M * DM || out_size != M * DM || ws_size < WS_END2) {
            fprintf(stderr, "kernel_launch: unexpected shapes n_in %d in0 %d out %d ws %zu\n", n_in, n_in > 0 ? in_sizes[0] : -1, out_size, ws_size); grid_blocks = -1; return; }
        int dev = 0, cus = 0, per_cu = 0;
        hipGetDevice(&dev);
        hipDeviceGetAttribute(&cus, hipDeviceAttributeMultiprocessorCount, dev);
        hipFuncSetAttribute((const void*)mega, hipFuncAttributeMaxDynamicSharedMemorySize, LDS_BYTES);
        hipOccupancyMaxActiveBlocksPerMultiprocessor(&per_cu, (const void*)mega, NTHREADS, LDS_BYTES);
        if (per_cu < 1) { fprintf(stderr, "kernel_launch: occupancy query says %d blocks per CU\n", per_cu); per_cu = 1; }
        grid_blocks = cus * per_cu;
        fprintf(stderr, "kernel_launch: %d CUs x %d = grid %d\n", cus, per_cu, grid_blocks);
    }
    if (grid_blocks < 0) return;
    Params p{};
    p.x = (const float*)d_in[0]; p.mem = (const float*)d_in[1]; p.pos = (const int*)d_in[2]; p.norm_gain = (const float*)d_in[3]; p.mem_norm_gain = (const float*)d_in[4];
    p.w_in = (const float*)d_in[5]; p.w_alpha = (const float*)d_in[6]; p.b_alpha = (const float*)d_in[7]; p.gla_out_norm = (const float*)d_in[8]; p.nsa_q_norm = (const float*)d_in[9];
    p.nsa_k_norm = (const float*)d_in[10]; p.pe_k = (const float*)d_in[11]; p.pe_v = (const float*)d_in[12]; p.wk1 = (const float*)d_in[13]; p.wk2 = (const float*)d_in[14];
    p.wv1 = (const float*)d_in[15]; p.wv2 = (const float*)d_in[16]; p.w_mem_kv = (const float*)d_in[17]; p.mem_q_norm = (const float*)d_in[18]; p.mem_k_norm = (const float*)d_in[19];
    p.w_branch = (const float*)d_in[20]; p.w_out = (const float*)d_in[21];
    p.out = (float*)d_out; p.ws = (unsigned char*)d_ws;
    if (hipMemsetAsync(d_ws, 0, 32768, stream) != hipSuccess) { fprintf(stderr, "kernel_launch: memset of the barrier words failed\n"); return; }
    void* args[] = {&p};
    hipError_t e = hipLaunchCooperativeKernel((const void*)mega, dim3(grid_blocks), dim3(NTHREADS), args, LDS_BYTES, stream);
    if (e != hipSuccess) fprintf(stderr, "cooperative launch failed: %s (grid %d)\n", hipGetErrorString(e), grid_blocks);
}
```

```cpp
#include <hip/hip_runtime.h>
#include <hip/hip_cooperative_groups.h>
#include <cstdio>
#include <cstdint>
namespace cg = cooperative_groups;

constexpr int NB = 2, SEQ = 8192, DM = 1024, M = NB * SEQ;
constexpr int DIN = 11840;
constexpr int C_GQ = 0, C_GK = 512, C_GV = 1024, C_LR = 2048, C_GG = 2064, C_NQ = 3088, C_NKV = 4112, C_NG = 5648,
              C_NGATE = 5696, C_MQ = 6720, C_MGATE = 7744, C_MERGE = 8768;
constexpr int NMEM = 256, NCMP = 511;
constexpr float EPS = 1e-6f;
constexpr int NTHREADS = 512, NWAVES = 8;
constexpr int LDS_BYTES = 147456;

constexpr size_t MiB = 1u << 20;
constexpr size_t WS_SM = 1 * MiB;
constexpr size_t WS_COS = 5 * MiB;
constexpr size_t WS_SIN = 7 * MiB;
constexpr size_t WS_KC = 9 * MiB;
constexpr size_t WS_VC = 11 * MiB;
constexpr size_t WS_MK = 13 * MiB;
constexpr size_t WS_MV = 15 * MiB;
constexpr size_t WS_RSTD = 17 * MiB;
constexpr size_t WS_MEMN = 18 * MiB;
constexpr size_t WS_GQK = 20 * MiB;
constexpr size_t WS_GV = 52 * MiB;
constexpr size_t WS_NQ = 84 * MiB;
constexpr size_t WS_NKV = 116 * MiB;
constexpr size_t WS_MQ = 164 * MiB;
constexpr size_t WS_END = 196 * MiB;
constexpr size_t WS_MKB = WS_KC + 1 * MiB;
constexpr size_t WS_MVT = WS_VC + 1 * MiB;

typedef unsigned short bf16_t;
__device__ __forceinline__ float bf2f(bf16_t v) { return __uint_as_float(((unsigned)v) << 16); }
__device__ __forceinline__ bf16_t f2bf(float f) { unsigned u = __float_as_uint(f); return (bf16_t)((u + 0x7fffu + ((u >> 16) & 1u)) >> 16); }
__device__ __forceinline__ float wave_sum(float v) {
#pragma unroll
    for (int o = 1; o < 64; o <<= 1) v += __shfl_xor(v, o);
    return v;
}
__device__ __forceinline__ float wave_max(float v) {
#pragma unroll
    for (int o = 1; o < 64; o <<= 1) v = fmaxf(v, __shfl_xor(v, o));
    return v;
}
__device__ __forceinline__ float sigmoidf_(float x) { return 1.f / (1.f + expf(-x)); }
__device__ __forceinline__ float fsig(float x) { return __builtin_amdgcn_rcpf(1.f + __builtin_amdgcn_exp2f(-1.4426950408889634f * x)); }
__device__ __forceinline__ float fsilu(float x) { return x * fsig(x); }

struct Params {
    const float* x; const float* mem; const int* pos; const float* norm_gain; const float* mem_norm_gain; const float* w_in;
    const float* w_alpha; const float* b_alpha; const float* gla_out_norm; const float* nsa_q_norm; const float* nsa_k_norm;
    const float* pe_k; const float* pe_v; const float* wk1; const float* wk2; const float* wv1; const float* wv2;
    const float* w_mem_kv; const float* mem_q_norm; const float* mem_k_norm; const float* w_branch; const float* w_out;
    float* out; unsigned char* ws;
};


constexpr int R_E = 0;
constexpr int R_SMALL = 5632;
constexpr int R_MKV = 5888;
constexpr int R_G = 7936;
constexpr int R_M = 11008;
constexpr int R_B = 14080;
constexpr int R_O = 17152;
constexpr int R_END = 18176;
constexpr size_t WS_BT = 196 * MiB;
constexpr size_t WS_END2 = WS_BT + (size_t)R_END * 1024 * 2;
static_assert(WS_END2 <= 256 * MiB, "workspace map");
constexpr size_t WS_UK = 232 * MiB;
constexpr size_t OUT_UV = 33 * MiB;
constexpr size_t WS_H1 = 248 * MiB;
constexpr size_t WS_W2T = 254 * MiB;
constexpr size_t WS_BTC = 252 * MiB;
static_assert(WS_END2 <= WS_UK, "workspace map");
constexpr size_t WS_GSCR = WS_NKV;

#define LAS __attribute__((address_space(3)))
typedef float f32x4 __attribute__((ext_vector_type(4)));
typedef unsigned u32x4 __attribute__((ext_vector_type(4)));
typedef unsigned u32x2 __attribute__((ext_vector_type(2)));

namespace pg8 {
#define PG8_LAS __attribute__((address_space(3)))
typedef unsigned short bf16_t;
typedef short bf16x8 __attribute__((ext_vector_type(8)));
typedef float f32x4 __attribute__((ext_vector_type(4)));
typedef unsigned u32x4 __attribute__((ext_vector_type(4)));
constexpr int BM = 256, BK = 64, HALF = 128, HTB = HALF * BK * 2  , STAGE_BYTES = 8 * HTB, NXCD = 8, WGM = 8;

__host__ __device__ __forceinline__ int lds_byte(int r, int c) { const int st = (r >> 4) * 2 + (c >> 5), rr = r & 15, cc = c & 31, ob = rr * 64 + cc * 2; return st * 1024 + (ob ^ (((ob >> 9) & 1) << 5)); }
__host__ __device__ __forceinline__ void stage_rc(int b, int& R, int& C) { const int st = b / 1024, sb = b % 1024, swz = sb ^ (((sb >> 9) & 1) << 5); R = (st >> 1) * 16 + swz / 64; C = (st & 1) * 32 + (swz % 64) / 2; }
__host__ __device__ __forceinline__ int perm32(int rho) { const int n = rho >> 4, i = rho & 15; return 8 * (i >> 2) + 4 * n + (i & 3); }

struct Unit { int pm, pn, tag; };
struct Gemm { int K; };
typedef float f32x2_cv __attribute__((ext_vector_type(2))); typedef __bf16 bf16x2_cv __attribute__((ext_vector_type(2)));
__device__ __forceinline__ unsigned cvt_pk_bf16(float lo, float hi) { const f32x2_cv v = {lo, hi}; return __builtin_bit_cast(unsigned, __builtin_convertvector(v, bf16x2_cv)); }
template <class Epi, class Sched, bool ALIGN_EPI = false, bool SP2 = false>
__device__ __forceinline__ void gemm_phase(PG8_LAS unsigned char* lds, const Gemm g, const Sched& S, const Epi& E) {
    int tid_ = threadIdx.x; asm volatile("" : "+v"(tid_));
    const int tid = tid_, wid = __builtin_amdgcn_readfirstlane(tid >> 6), lane = tid & 63, wr = wid >> 2, wc = wid & 3, fr = lane & 15, fq = lane >> 4;
    const int K = g.K, nt = K / BK;
    unsigned voffA[2], voffB[2];
#pragma unroll
    for (int i = 0; i < 2; ++i) { int R, C; stage_rc(tid * 16 + i * 8192, R, C); const int Rb = Epi::PERM ? ((R & ~31) + perm32(R & 31)) : R;
        voffA[i] = (unsigned)(R * K + C) * 2u; voffB[i] = (unsigned)(Rb * K + C) * 2u; }
    const size_t kstep = (size_t)(BK * 2);
    const size_t hstep = (size_t)HALF * K * 2;
    const size_t tstep = 2 * hstep;
    const unsigned ldsw = (unsigned)wid * 1024u;
    const int aoff = lds_byte(wr * 64 + fr, fq * 8), boff = lds_byte(wc * 32 + fr, fq * 8);
#define PG8_SA(b, h) (((b) * 2 + (h)) * HTB)
#define PG8_SB(b, h) ((4 + (b) * 2 + (h)) * HTB)
#define PG8_STAGE(bufoff, gbase, voff) do { _Pragma("unroll") for (int _i = 0; _i < 2; ++_i) \
        __builtin_amdgcn_global_load_lds((const unsigned*)((const char*)(gbase) + (voff)[_i]), (PG8_LAS unsigned*)(lds + (bufoff) + ldsw + _i * 8192), 16, 0, 0); } while (0)
#define PG8_LDA(dst, b, h) do { _Pragma("unroll") for (int m = 0; m < 4; ++m) _Pragma("unroll") for (int k = 0; k < 2; ++k) dst[m][k] = *(const PG8_LAS bf16x8*)(lds + PG8_SA(b, h) + aoff + m * 2048 + k * 1024); } while (0)
#define PG8_LDB(dst, b, h) do { _Pragma("unroll") for (int n = 0; n < 2; ++n) _Pragma("unroll") for (int k = 0; k < 2; ++k) dst[n][k] = *(const PG8_LAS bf16x8*)(lds + PG8_SB(b, h) + boff + n * 2048 + k * 1024); } while (0)
#define PG8_MMA(ai, bj, At, Bt) do { __builtin_amdgcn_s_setprio(1); _Pragma("unroll") for (int m = 0; m < 4; ++m) _Pragma("unroll") for (int n = 0; n < 2; ++n) _Pragma("unroll") for (int k = 0; k < 2; ++k) \
        acc[ai][bj][m][n] = __builtin_amdgcn_mfma_f32_16x16x32_bf16(Bt[n][k], At[m][k], acc[ai][bj][m][n], 0, 0, 0); __builtin_amdgcn_s_setprio(0); } while (0)
#define PG8_WAIT_V(n) asm volatile("s_waitcnt vmcnt(" #n ")" ::: "memory")
#define PG8_WAIT_L(n) asm volatile("s_waitcnt lgkmcnt(" #n ")" ::: "memory")
#define PG8_BAR __builtin_amdgcn_s_barrier()
#define PG8_SCHED __builtin_amdgcn_sched_barrier(0)
    Unit cur, nxt; int ui = 0;
    if (!S.next(0, cur)) return;
    f32x4 acc[2][2][4][2];
#pragma unroll
    for (int a = 0; a < 2; ++a)
#pragma unroll
        for (int b = 0; b < 2; ++b)
#pragma unroll
            for (int m = 0; m < 4; ++m)
#pragma unroll
                for (int n = 0; n < 2; ++n) acc[a][b][m][n] = (f32x4){0.f, 0.f, 0.f, 0.f};
    bf16x8 At[4][2], B0[2][2], B1[2][2];
    const char* cA = S.pa(cur); const char* cB = S.pb(cur);
    S.a_ready(cur);
    if constexpr (SP2) {
        PG8_STAGE(PG8_SB(0, 0), cB, voffB); PG8_STAGE(PG8_SB(0, 1), cB + hstep, voffB); PG8_STAGE(PG8_SA(0, 0), cA, voffA); PG8_STAGE(PG8_SA(0, 1), cA + hstep, voffA);
        if (wr == 1) PG8_BAR;
        PG8_WAIT_V(2); PG8_BAR;
        PG8_STAGE(PG8_SB(1, 0), cB + kstep, voffB); PG8_STAGE(PG8_SA(1, 0), cA + kstep, voffA); PG8_STAGE(PG8_SB(1, 1), cB + hstep + kstep, voffB);
        PG8_WAIT_V(6); PG8_BAR;
    } else {
        PG8_STAGE(PG8_SB(0, 0), cB, voffB); PG8_STAGE(PG8_SA(0, 0), cA, voffA); PG8_STAGE(PG8_SB(0, 1), cB + hstep, voffB); PG8_STAGE(PG8_SA(0, 1), cA + hstep, voffA);
        if (wr == 1) PG8_BAR;
        PG8_WAIT_V(4); PG8_BAR;
        PG8_STAGE(PG8_SB(1, 0), cB + kstep, voffB); PG8_STAGE(PG8_SA(1, 0), cA + kstep, voffA); PG8_STAGE(PG8_SB(1, 1), cB + hstep + kstep, voffB);
        PG8_WAIT_V(6); PG8_BAR;
    }
    for (;;) {
        const bool has_next = S.next(ui + 1, nxt);
        const char* nA = has_next ? S.pa(nxt) : cA; const char* nB = has_next ? S.pb(nxt) : cB;
        for (int t = 0; t < nt; t += 2) {
            const bool last = (t == nt - 2);
            const char* a1 = cA + (size_t)(t + 1) * kstep;
            const char* a2 = last ? nA : cA + (size_t)(t + 2) * kstep; const char* b2 = last ? nB : cB + (size_t)(t + 2) * kstep;
            const char* a3 = a2 + kstep; const char* b3 = b2 + kstep;
            if (last && has_next) S.a_ready(nxt);
            if constexpr (SP2) {
            PG8_LDB(B0, 0, 0); PG8_LDB(B1, 0, 1); PG8_SCHED; PG8_LDA(At, 0, 0); PG8_STAGE(PG8_SA(1, 1), a1 + hstep, voffA);
            PG8_WAIT_V(8); PG8_WAIT_L(0); PG8_BAR; PG8_MMA(0, 0, At, B0); PG8_MMA(0, 1, At, B1); PG8_BAR; PG8_SCHED;
            PG8_LDA(At, 0, 1); PG8_STAGE(PG8_SB(0, 0), b2, voffB); PG8_STAGE(PG8_SB(0, 1), b2 + hstep, voffB); PG8_STAGE(PG8_SA(0, 0), a2, voffA);
            PG8_WAIT_V(8); PG8_WAIT_L(0); PG8_BAR; PG8_MMA(1, 0, At, B0); PG8_MMA(1, 1, At, B1); PG8_BAR; PG8_SCHED;
            PG8_LDB(B0, 1, 0); PG8_LDB(B1, 1, 1); PG8_SCHED; PG8_LDA(At, 1, 0); PG8_STAGE(PG8_SA(0, 1), a2 + hstep, voffA);
            PG8_WAIT_V(8); PG8_WAIT_L(0); PG8_BAR; PG8_MMA(0, 0, At, B0); PG8_MMA(0, 1, At, B1); PG8_BAR; PG8_SCHED;
            PG8_LDA(At, 1, 1); PG8_STAGE(PG8_SB(1, 0), b3, voffB); PG8_STAGE(PG8_SB(1, 1), b3 + hstep, voffB); PG8_STAGE(PG8_SA(1, 0), a3, voffA);
            PG8_WAIT_V(8); PG8_WAIT_L(0); PG8_BAR; PG8_MMA(1, 0, At, B0); PG8_MMA(1, 1, At, B1); PG8_BAR; PG8_SCHED;
            } else {
            PG8_LDB(B0, 0, 0); PG8_SCHED; PG8_LDA(At, 0, 0); PG8_STAGE(PG8_SA(1, 1), a1 + hstep, voffA);
            PG8_WAIT_L(8); PG8_BAR; PG8_WAIT_L(0); PG8_MMA(0, 0, At, B0); PG8_BAR; PG8_SCHED;
            PG8_LDB(B1, 0, 1); PG8_STAGE(PG8_SB(0, 0), b2, voffB);
            PG8_BAR; PG8_WAIT_L(0); PG8_MMA(0, 1, At, B1); PG8_BAR;
            PG8_LDA(At, 0, 1); PG8_STAGE(PG8_SA(0, 0), a2, voffA);
            PG8_BAR; PG8_WAIT_L(0); PG8_MMA(1, 0, At, B0); PG8_BAR; PG8_SCHED;
            PG8_STAGE(PG8_SB(0, 1), b2 + hstep, voffB);
            PG8_WAIT_V(6); PG8_BAR; PG8_MMA(1, 1, At, B1); PG8_BAR;
            PG8_LDB(B0, 1, 0); PG8_SCHED; PG8_LDA(At, 1, 0); PG8_STAGE(PG8_SA(0, 1), a2 + hstep, voffA);
            PG8_WAIT_L(8); PG8_BAR; PG8_WAIT_L(0); PG8_MMA(0, 0, At, B0); PG8_BAR; PG8_SCHED;
            PG8_LDB(B1, 1, 1); PG8_STAGE(PG8_SB(1, 0), b3, voffB);
            PG8_BAR; PG8_WAIT_L(0); PG8_MMA(0, 1, At, B1); PG8_BAR;
            PG8_LDA(At, 1, 1); PG8_STAGE(PG8_SA(1, 0), a3, voffA);
            PG8_BAR; PG8_WAIT_L(0); PG8_MMA(1, 0, At, B0); PG8_BAR; PG8_SCHED;
            PG8_STAGE(PG8_SB(1, 1), b3 + hstep, voffB);
            PG8_WAIT_V(6); PG8_BAR; PG8_MMA(1, 1, At, B1); PG8_BAR;
            }
        }
        if constexpr (ALIGN_EPI) { if (wr == 0) PG8_BAR; }
        if constexpr (!Epi::AFTER_DRAIN) { E(acc, cur, wr, wc, fr, fq); S.done(cur); }
        if (!has_next) break;
#pragma unroll
        for (int a = 0; a < 2; ++a)
#pragma unroll
            for (int b = 0; b < 2; ++b)
#pragma unroll
                for (int m = 0; m < 4; ++m)
#pragma unroll
                    for (int n = 0; n < 2; ++n) acc[a][b][m][n] = (f32x4){0.f, 0.f, 0.f, 0.f};
        cur = nxt; cA = nA; cB = nB; ++ui;
        if constexpr (ALIGN_EPI) { if (wr == 1) PG8_BAR; }
    }
    PG8_WAIT_V(0);
    if constexpr (!ALIGN_EPI) { if (wr == 0) PG8_BAR; }
    PG8_BAR;
    if constexpr (Epi::AFTER_DRAIN) { E.fused(acc, cur, wr, wc, fr, fq, lds, wid, lane); S.done(cur); }
#undef PG8_SA
#undef PG8_SB
#undef PG8_STAGE
#undef PG8_LDA
#undef PG8_LDB
#undef PG8_MMA
#undef PG8_WAIT_V
#undef PG8_WAIT_L
#undef PG8_BAR
#undef PG8_SCHED
}
}

#define RLX_AGENT __ATOMIC_RELAXED, __HIP_MEMORY_SCOPE_AGENT
#define XB_TMO      128
#define XB_XCNT(j)  (256  + 64 * (j))
#define XB_XSUB(j)  (1280 + 64 * (j))
#define XB_XGEN(j)  (2304 + 64 * (j))
#define XB_TOP      3328
#define XB_TOPGEN   3392
#define XCD_BAR_WORDS 3456
#define XB_SPIN_CAP (1u << 18)

__device__ __forceinline__ unsigned xb_ld(unsigned* p)              { return __hip_atomic_load(p, __ATOMIC_RELAXED, __HIP_MEMORY_SCOPE_AGENT); }
__device__ __forceinline__ unsigned xb_add(unsigned* p, unsigned v) { return __hip_atomic_fetch_add(p, v, __ATOMIC_RELAXED, __HIP_MEMORY_SCOPE_AGENT); }
__device__ __forceinline__ unsigned xb_xcc_id() { return (unsigned)__builtin_amdgcn_s_getreg((3 << 11) | 20) & 0xFu; }
#define XB_SPIN(cond, bar) do { unsigned _sp = 0; while (cond) { __builtin_amdgcn_s_sleep(1); \
    if ((++_sp & 255u) == 0u) { if (xb_ld(&(bar)[XB_TMO])) break; if (_sp > XB_SPIN_CAP) { atomicAdd(&(bar)[XB_TMO], 1u); break; } } } } while (0)

struct XcdBarrier {
    unsigned* bar; unsigned x;
    volatile LAS unsigned* st;
};

__device__ __forceinline__ XcdBarrier xcd_barrier_post(unsigned* bar, volatile LAS unsigned* st) {
    XcdBarrier b; b.bar = bar; b.x = xb_xcc_id(); b.st = st;
    if (threadIdx.x == 0) (void)xb_add(&bar[XB_XCNT(b.x)], 1u);
    return b;
}
__device__ __forceinline__ void xcd_barrier_complete(unsigned* bar, unsigned x, unsigned& nloc, unsigned& nx) {
    const unsigned G = gridDim.x * gridDim.y * gridDim.z;
    unsigned sum, cnt, mine, sp = 0u;
    for (;;) {
        sum = 0u; cnt = 0u; mine = 0u;
#pragma unroll
        for (unsigned j = 0; j < 16; ++j) { const unsigned c = xb_ld(&bar[XB_XCNT(j)]); sum += c; cnt += (c > 0u) ? 1u : 0u; mine = (j == x) ? c : mine; }
        if (sum == G) break;
        __builtin_amdgcn_s_sleep(1);
        if ((++sp & 255u) == 0u) { if (xb_ld(&bar[XB_TMO])) break; if (sp > XB_SPIN_CAP) { atomicAdd(&bar[XB_TMO], 1u); break; } }
    }
    nloc = mine > 0u ? mine : 1u; nx = cnt > 0u ? cnt : 1u;
}

__device__ __forceinline__ void xcd_barrier(const XcdBarrier& b) {
    asm volatile("s_waitcnt vmcnt(0)" ::: "memory");
    __syncthreads();
    if (threadIdx.x == 0) {
        unsigned* bar = b.bar;
        __builtin_amdgcn_s_waitcnt(0);
        unsigned nloc = b.st[0], nx = b.st[1];
        if (nloc == 0u) { xcd_barrier_complete(bar, b.x, nloc, nx); b.st[0] = nloc; b.st[1] = nx; }
        const unsigned old = xb_add(&bar[XB_XSUB(b.x)], 1u);
        const unsigned gen = old / nloc;
        if (old + 1u == (gen + 1u) * nloc) {
            __builtin_amdgcn_fence(__ATOMIC_RELEASE, "agent");
            asm volatile("s_waitcnt vmcnt(0)" ::: "memory");
            const unsigned og = xb_add(&bar[XB_TOP], 1u);
            const unsigned tg = og / nx;
            if (og + 1u == (tg + 1u) * nx) xb_add(&bar[XB_TOPGEN], 1u);
            else XB_SPIN(xb_ld(&bar[XB_TOPGEN]) == tg, bar);
            __builtin_amdgcn_fence(__ATOMIC_ACQUIRE, "agent");
            xb_add(&bar[XB_XGEN(b.x)], 1u);
            asm volatile("s_waitcnt vmcnt(0)" ::: "memory");
        } else {
            XB_SPIN(xb_ld(&bar[XB_XGEN(b.x)]) == gen, bar);
            __builtin_amdgcn_fence(__ATOMIC_ACQUIRE, "agent");
            asm volatile("s_waitcnt vmcnt(0)" ::: "memory");
        }
    }
    __syncthreads();
}

struct SchedEarly {
    const char* A; const char* B; int G, c;
    static constexpr int nM = 64, nN = 23, nwg = nM * nN, nx = 16;
    __device__ __forceinline__ bool next(int i, pg8::Unit& u) const {
        const int L = i * G + c; if (L >= nwg + nx) return false;
        if (L >= nwg) { const int e = L - nwg; u.pm = 64 + (e >> 3); u.pn = 23 + (e & 7); u.tag = 1; return true; }
        int wgid = L; { const int q = nwg / 8, xcd = wgid % 8, off = wgid / 8; wgid = xcd * q + off; }
        const int nig = 8 * nN, gid = wgid / nig, fm = gid * 8;
        const int s = (wgid % nig) / 8;
        const unsigned long long tab = s < 12 ? 0x5a928398a418820ull : 0x5272ada2f6c1ccull;
        u.pm = fm + ((wgid % nig) % 8); u.pn = (int)((tab >> (5 * (s < 12 ? s : s - 12))) & 31u); u.tag = 0; return true;
    }
    __device__ __forceinline__ const char* pa(const pg8::Unit& u) const { return A + (size_t)u.pm * (256 * 1024 * 2); }
    __device__ __forceinline__ const char* pb(const pg8::Unit& u) const { return B + (size_t)u.pn * (256 * 1024 * 2); }
    __device__ __forceinline__ void a_ready(const pg8::Unit&) const {}
    __device__ __forceinline__ void done(const pg8::Unit&) const {}
};
struct SchedPlain {
    const char* A; const char* B; int nN, nwg, G, c;
    __device__ __forceinline__ bool next(int i, pg8::Unit& u) const {
        const int L = i * G + c; if (L >= nwg) return false;
        int wgid = L; { const int q = nwg / 8, xcd = wgid % 8, off = wgid / 8; wgid = xcd * q + off; }
        const int nig = 8 * nN, gid = wgid / nig, fm = gid * 8;
        u.pm = fm + ((wgid % nig) % 8); u.pn = (wgid % nig) / 8; u.tag = 0; return true;
    }
    __device__ __forceinline__ const char* pa(const pg8::Unit& u) const { return A + (size_t)u.pm * (256 * 1024 * 2); }
    __device__ __forceinline__ const char* pb(const pg8::Unit& u) const { return B + (size_t)u.pn * (256 * 1024 * 2); }
    __device__ __forceinline__ void a_ready(const pg8::Unit&) const {}
    __device__ __forceinline__ void done(const pg8::Unit&) const {}
};
struct SchedMix {
    const char* XN; const char* Y0; const char* Y1; const char* Y2; const char* BM_; const char* BB; int G, c;
    __device__ __forceinline__ bool next(int i, pg8::Unit& u) const {
        const int tl = (i / 6) * G + c; if (tl >= 256) return false;
        int wgid = tl; { const int xcd = wgid % 8, off = wgid / 8; wgid = xcd * 32 + off; }
        const int gid = wgid / 32, fm = gid * 8;
        u.pm = fm + ((wgid % 32) % 8); u.pn = (wgid % 32) / 8; u.tag = i % 6; return true;
    }
    __device__ __forceinline__ const char* pa(const pg8::Unit& u) const {
        const int cc = u.tag >> 1; const char* base = (u.tag & 1) ? (cc == 0 ? Y0 : (cc == 1 ? Y1 : Y2)) : XN;
        return base + (size_t)u.pm * (256 * 1024 * 2); }
    __device__ __forceinline__ const char* pb(const pg8::Unit& u) const {
        const int cc = u.tag >> 1; return ((u.tag & 1) ? BB : BM_) + (size_t)(cc * 4 + u.pn) * (256 * 1024 * 2); }
    __device__ __forceinline__ void a_ready(const pg8::Unit&) const {}
    __device__ __forceinline__ void done(const pg8::Unit&) const {}
};

__device__ __forceinline__ float fq_sum(float x) {
    const auto r = __builtin_amdgcn_permlane16_swap(__float_as_uint(x), __float_as_uint(x), false, false);
    const float s = __uint_as_float(r[0]) + __uint_as_float(r[1]);
    const auto q = __builtin_amdgcn_permlane32_swap(__float_as_uint(s), __float_as_uint(s), false, false);
    return __uint_as_float(q[0]) + __uint_as_float(q[1]);
}
struct EpiEarly {
    static constexpr bool PERM = true, AFTER_DRAIN = false;
    unsigned char* ws; PG8_LAS unsigned char* lds; bf16_t* UV;
    const float* nsa_q_norm; const float* nsa_k_norm; const float* pe_k; const float* pe_v; const float* mem_q_norm; const float* mem_k_norm;
    static constexpr int XS = 131072;
    __device__ __forceinline__ void operator()(const pg8::f32x4 (&acc)[2][2][4][2], const pg8::Unit& u, int wr, int wc, int fr_, int fq_) const {
        int fr = fr_, fq = fq_; asm volatile("" : "+v"(fr), "+v"(fq));
        const int pn = u.pn;
        const bool headtile = (pn >= 8 && pn < 15) || pn == 16;
        if (pn < 8 || pn == 15 || pn == 17) {
            bf16_t* base; int ldc = 1024, colt; float sc = 1.f;
            if (pn < 4) { base = (bf16_t*)(ws + WS_GQK); colt = pn * 256; if (pn < 2) sc = 0.08838834764831845f; }
            else if (pn < 8) { base = (bf16_t*)(ws + WS_GV); colt = (pn - 4) * 256; }
            else { base = (bf16_t*)(ws + WS_NKV); colt = (pn - 12) * 256; ldc = 1536; }
            const int row0 = u.pm * 256 + wr * 64 + fr, col0 = colt + wc * 32 + 8 * fq;
#pragma unroll
            for (int ai = 0; ai < 2; ++ai)
#pragma unroll
                for (int m = 0; m < 4; ++m) { bf16_t* rowp = base + (size_t)(row0 + ai * 128 + m * 16) * ldc + col0;
#pragma unroll
                    for (int bj = 0; bj < 2; ++bj) { const pg8::f32x4 v0 = acc[ai][bj][m][0] * sc, v1 = acc[ai][bj][m][1] * sc; u32x4 w;
                        w.x = pg8::cvt_pk_bf16(v0[0], v0[1]); w.y = pg8::cvt_pk_bf16(v0[2], v0[3]); w.z = pg8::cvt_pk_bf16(v1[0], v1[1]); w.w = pg8::cvt_pk_bf16(v1[2], v1[3]);
                        *(u32x4*)(rowp + bj * 128) = w; } }
        } else if (headtile) {
            const bool isq = pn < 12, isv = pn == 13, iscmp = (pn == 12 || pn == 13);
            const float* gn = isq ? nsa_q_norm : (nsa_k_norm + ((pn - 12) >> 1) * 64);
            const float osc = isq ? 0.125f * 1.4426950408889634f : 1.f;
            float ga[8], gb[8];
            { const f32x4 g0 = *(const f32x4*)(gn + 8 * fq), g1 = *(const f32x4*)(gn + 8 * fq + 4), g2 = *(const f32x4*)(gn + 32 + 8 * fq), g3 = *(const f32x4*)(gn + 36 + 8 * fq);
#pragma unroll
              for (int e = 0; e < 4; ++e) { ga[e] = g0[e] * osc; ga[4 + e] = g1[e] * osc; gb[e] = g2[e] * osc; gb[4 + e] = g3[e] * osc; } }
            const float* COS = (const float*)(ws + WS_COS); const float* SIN = (const float*)(ws + WS_SIN);
            bf16_t* obase = isq ? ((bf16_t*)(ws + WS_NQ) + (pn - 8) * 256) : ((bf16_t*)(ws + WS_NKV) + (pn - 12) * 256);
            const int ldc = isq ? 1024 : 1536;
            bf16_t* U = isv ? UV : (bf16_t*)(ws + WS_UK); const float* pe = isv ? pe_v : pe_k;
            const int row0 = u.pm * 256 + wr * 64 + fr;
            f32x4 tb[2][4];
#define EE_LDT(r, d) do { const size_t to_ = (size_t)(row0 + ((r) >> 2) * 128 + ((r) & 3) * 16) * 32 + 8 * fq; d[0] = *(const f32x4*)(COS + to_); d[1] = *(const f32x4*)(COS + to_ + 4); d[2] = *(const f32x4*)(SIN + to_); d[3] = *(const f32x4*)(SIN + to_ + 4); } while (0)
            if (!isv) EE_LDT(0, tb[0]);
#pragma unroll
            for (int r = 0; r < 8; ++r) {
                    const int ai = r >> 2, m = r & 3;
                    const int t = row0 + ai * 128 + m * 16;
                    if (!isv && r < 7) EE_LDT(r + 1, tb[(r + 1) & 1]);
                    const pg8::f32x4 x0 = acc[ai][0][m][0], x1 = acc[ai][0][m][1], y0 = acc[ai][1][m][0], y1 = acc[ai][1][m][1];
                    float a[8] = {x0[0], x0[1], x0[2], x0[3], x1[0], x1[1], x1[2], x1[3]};
                    float b[8] = {y0[0], y0[1], y0[2], y0[3], y1[0], y1[1], y1[2], y1[3]};
                    if (!isv) {
                        float ss = 0.f;
#pragma unroll
                        for (int e = 0; e < 8; ++e) ss += a[e] * a[e] + b[e] * b[e];
                        const float rs = rsqrtf(fq_sum(ss) * (1.f / 64.f) + EPS);
                        const f32x4 c0 = tb[r & 1][0], c1 = tb[r & 1][1], s0 = tb[r & 1][2], s1 = tb[r & 1][3];
#pragma unroll
                        for (int e = 0; e < 8; ++e) { const float cc = (e < 4 ? c0[e & 3] : c1[e & 3]) * rs, sn = (e < 4 ? s0[e & 3] : s1[e & 3]) * rs;
                            const float ya = a[e] * ga[e], yb = b[e] * gb[e]; a[e] = ya * cc - yb * sn; b[e] = yb * cc + ya * sn; }
                    }
                    if (!iscmp) {
                        bf16_t* op = obase + (size_t)t * ldc + wc * 64 + 8 * fq; u32x4 oa, ob;
                        oa.x = pg8::cvt_pk_bf16(a[0], a[1]); oa.y = pg8::cvt_pk_bf16(a[2], a[3]); oa.z = pg8::cvt_pk_bf16(a[4], a[5]); oa.w = pg8::cvt_pk_bf16(a[6], a[7]);
                        ob.x = pg8::cvt_pk_bf16(b[0], b[1]); ob.y = pg8::cvt_pk_bf16(b[2], b[3]); ob.z = pg8::cvt_pk_bf16(b[4], b[5]); ob.w = pg8::cvt_pk_bf16(b[6], b[7]);
                        *(u32x4*)op = oa; *(u32x4*)(op + 32) = ob;
                    } else {
                        const int bb = t / SEQ, ts = t % SEQ, n1 = ts >> 4;
#pragma unroll
                        for (int rep = 0; rep < 2; ++rep) {
                            const int n = n1 - rep, ll = fr + 16 * rep;
                            if (n >= 0 && n < NCMP) {
                                const float* pp = pe + ll * 64 + 8 * fq;
                                const f32x4 pa0 = *(const f32x4*)pp, pa1 = *(const f32x4*)(pp + 4), pb0 = *(const f32x4*)(pp + 32), pb1 = *(const f32x4*)(pp + 36);
                                u32x4 oa, ob;
                                oa.x = pg8::cvt_pk_bf16(a[0] + pa0[0], a[1] + pa0[1]); oa.y = pg8::cvt_pk_bf16(a[2] + pa0[2], a[3] + pa0[3]); oa.z = pg8::cvt_pk_bf16(a[4] + pa1[0], a[5] + pa1[1]); oa.w = pg8::cvt_pk_bf16(a[6] + pa1[2], a[7] + pa1[3]);
                                ob.x = pg8::cvt_pk_bf16(b[0] + pb0[0], b[1] + pb0[1]); ob.y = pg8::cvt_pk_bf16(b[2] + pb0[2], b[3] + pb0[3]); ob.z = pg8::cvt_pk_bf16(b[4] + pb1[0], b[5] + pb1[1]); ob.w = pg8::cvt_pk_bf16(b[6] + pb1[2], b[7] + pb1[3]);
                                bf16_t* up = U + ((size_t)(bb * NCMP + n) * 4 + wc) * 2048 + ll * 64 + 8 * fq;
                                *(u32x4*)up = oa; *(u32x4*)(up + 32) = ob;
                            }
                        }
                    }
            }
#undef EE_LDT
        } else if (pn == 22) {
            if (wc < 2) { float* SM = (float*)(ws + WS_SM); const int row0 = u.pm * 256 + wr * 64 + fr, col0 = wc * 32 + 8 * fq;
#pragma unroll
                for (int ai = 0; ai < 2; ++ai)
#pragma unroll
                    for (int m = 0; m < 4; ++m) { float* rowp = SM + (size_t)(row0 + ai * 128 + m * 16) * 64 + col0;
                        *(pg8::f32x4*)(rowp) = acc[ai][0][m][0]; *(pg8::f32x4*)(rowp + 4) = acc[ai][0][m][1]; } }
        } else if (pn >= 27) {
            bf16_t* MVT = (bf16_t*)(ws + WS_MVT) + (size_t)((u.pm - 64) * 4 + (pn - 27)) * 65536;
            const int m0 = wr * 64 + fr, d0 = wc * 32 + 8 * fq;
#pragma unroll
            for (int ai = 0; ai < 2; ++ai)
#pragma unroll
                for (int m = 0; m < 4; ++m)
#pragma unroll
                    for (int bj = 0; bj < 2; ++bj)
#pragma unroll
                        for (int e = 0; e < 8; ++e) MVT[(size_t)(d0 + bj * 128 + e) * 256 + m0 + ai * 128 + m * 16] = f2bf(acc[ai][bj][m][e >> 2][e & 3]);
        } else {
            const bool isk = pn >= 23;
            PG8_LAS float* xs = (PG8_LAS float*)(lds + XS) + wr * 512;
            float ssr[8];
#pragma unroll
            for (int ai = 0; ai < 2; ++ai)
#pragma unroll
                for (int m = 0; m < 4; ++m) { float ss = 0.f;
#pragma unroll
                    for (int bj = 0; bj < 2; ++bj)
#pragma unroll
                        for (int n = 0; n < 2; ++n) { const pg8::f32x4 v = acc[ai][bj][m][n]; ss += v[0] * v[0] + v[1] * v[1] + v[2] * v[2] + v[3] * v[3]; }
                    ss = fq_sum(ss);
                    if (fq == 0) xs[(ai * 64 + m * 16 + fr) * 4 + wc] = ss; }
            asm volatile("s_waitcnt lgkmcnt(0)" ::: "memory"); __builtin_amdgcn_s_barrier(); asm volatile("" ::: "memory");
#pragma unroll
            for (int ai = 0; ai < 2; ++ai)
#pragma unroll
                for (int m = 0; m < 4; ++m) { const f32x4 q4 = *(const PG8_LAS f32x4*)(xs + (ai * 64 + m * 16 + fr) * 4); ssr[ai * 4 + m] = q4[0] + q4[1] + q4[2] + q4[3]; }
            const float* gn = isk ? mem_k_norm : mem_q_norm; const float osc = isk ? 1.f : 0.0625f * 1.4426950408889634f;
            const int c0 = wc * 32 + 8 * fq;
            bf16_t* obase = isk ? ((bf16_t*)(ws + WS_MKB) + (size_t)((u.pm - 64) * 4 + (pn - 23)) * 65536) : ((bf16_t*)(ws + WS_MQ) + (size_t)u.pm * 256 * 1024 + (pn - 18) * 256);
            const int ldc = isk ? 256 : 1024;
#pragma unroll
            for (int bj = 0; bj < 2; ++bj) {
                const f32x4 g0 = *(const f32x4*)(gn + c0 + bj * 128) * osc, g1 = *(const f32x4*)(gn + c0 + bj * 128 + 4) * osc;
#pragma unroll
                for (int ai = 0; ai < 2; ++ai)
#pragma unroll
                    for (int m = 0; m < 4; ++m) { const float rs = rsqrtf(ssr[ai * 4 + m] * (1.f / 256.f) + EPS);
                        const pg8::f32x4 v0 = acc[ai][bj][m][0] * rs * g0, v1 = acc[ai][bj][m][1] * rs * g1; u32x4 w;
                        w.x = pg8::cvt_pk_bf16(v0[0], v0[1]); w.y = pg8::cvt_pk_bf16(v0[2], v0[3]); w.z = pg8::cvt_pk_bf16(v1[0], v1[1]); w.w = pg8::cvt_pk_bf16(v1[2], v1[3]);
                        *(u32x4*)(obase + (size_t)(wr * 64 + fr + ai * 128 + m * 16) * ldc + c0 + bj * 128) = w; }
            }
        }
    }
};
__device__ __forceinline__ float bflo(unsigned w) { return __uint_as_float(w << 16); }
__device__ __forceinline__ float bfhi(unsigned w) { return __uint_as_float(w & 0xffff0000u); }
struct EpiGates {
    static constexpr bool PERM = true, AFTER_DRAIN = false;
    unsigned char* ws;
    template <bool GLA>
    __device__ __forceinline__ void run(const pg8::f32x4 (&acc)[2][2][4][2], const pg8::Unit& u, int wr, int wc, int fr, int fq) const {
        const int pn = u.pn; const int br = pn >> 2;
        bf16_t* base = (bf16_t*)(ws + (GLA ? WS_GV : (br == 1 ? WS_NQ : WS_MQ)));
        const float* RSTD = (const float*)(ws + WS_RSTD);
        const int row0 = u.pm * 256 + wr * 64 + fr, col0 = (pn & 3) * 256 + wc * 32 + 8 * fq;
#pragma unroll
        for (int am = 0; am < 4; ++am) {
            const int ai = am >> 1, m0 = (am & 1) * 2;
            u32x4 ov[2][2]; f32x4 q4[2];
#pragma unroll
            for (int mm = 0; mm < 2; ++mm) { const int row = row0 + ai * 128 + (m0 + mm) * 16; const bf16_t* rowp = base + (size_t)row * 1024 + col0;
                ov[mm][0] = *(const u32x4*)rowp; ov[mm][1] = *(const u32x4*)(rowp + 128);
                if (GLA) q4[mm] = *(const f32x4*)(RSTD + (size_t)row * 16 + pn * 4); }
            __builtin_amdgcn_sched_barrier(0);
#pragma unroll
            for (int mm = 0; mm < 2; ++mm) { const int m = m0 + mm; const int row = row0 + ai * 128 + m * 16; bf16_t* rowp = base + (size_t)row * 1024 + col0;
                float rs = 1.f;
                if (GLA) rs = rsqrtf((q4[mm][0] + q4[mm][1] + q4[mm][2] + q4[mm][3]) * (1.f / 256.f) + EPS);
#pragma unroll
                for (int bj = 0; bj < 2; ++bj) { const u32x4 o = ov[mm][bj]; const pg8::f32x4 a0 = acc[ai][bj][m][0], a1 = acc[ai][bj][m][1];
                    u32x4 w;
                    w.x = pg8::cvt_pk_bf16(bflo(o.x) * rs * fsilu(a0[0]), bfhi(o.x) * rs * fsilu(a0[1]));
                    w.y = pg8::cvt_pk_bf16(bflo(o.y) * rs * fsilu(a0[2]), bfhi(o.y) * rs * fsilu(a0[3]));
                    w.z = pg8::cvt_pk_bf16(bflo(o.z) * rs * fsilu(a1[0]), bfhi(o.z) * rs * fsilu(a1[1]));
                    w.w = pg8::cvt_pk_bf16(bflo(o.w) * rs * fsilu(a1[2]), bfhi(o.w) * rs * fsilu(a1[3]));
                    *(u32x4*)(rowp + bj * 128) = w; } }
        }
    }
    __device__ __forceinline__ void operator()(const pg8::f32x4 (&acc)[2][2][4][2], const pg8::Unit& u, int wr, int wc, int fr_, int fq_) const {
        int fr = fr_, fq = fq_; asm volatile("" : "+v"(fr), "+v"(fq));
        if ((u.pn >> 2) == 0) run<true>(acc, u, wr, wc, fr, fq); else run<false>(acc, u, wr, wc, fr, fq);
    }
};
struct EpiMix {
    static constexpr bool PERM = true, AFTER_DRAIN = false;
    unsigned char* ws;
    template <bool ACCUM>
    __device__ __forceinline__ void run1(const pg8::f32x4 (&acc)[2][2][4][2], const pg8::Unit& u, int wr, int wc, int fr, int fq) const {
        const bf16_t* scr = (const bf16_t*)(ws + WS_GSCR) + (size_t)blockIdx.x * 65536;
        bf16_t* MIXED = (bf16_t*)(ws + WS_GQK);
        const int r0 = wr * 64 + fr, c0 = wc * 32 + 8 * fq;
#pragma unroll
        for (int am = 0; am < 4; ++am) {
            const int ai = am >> 1, m0 = (am & 1) * 2;
            u32x4 gv[2][2], ov[2][2];
#pragma unroll
            for (int mm = 0; mm < 2; ++mm) { const int rt = r0 + ai * 128 + (m0 + mm) * 16;
                const bf16_t* sp = scr + rt * 256 + c0; const bf16_t* mp = MIXED + (size_t)(u.pm * 256 + rt) * 1024 + u.pn * 256 + c0;
                gv[mm][0] = *(const u32x4*)sp; gv[mm][1] = *(const u32x4*)(sp + 128);
                if (ACCUM) { ov[mm][0] = *(const u32x4*)mp; ov[mm][1] = *(const u32x4*)(mp + 128); } }
            __builtin_amdgcn_sched_barrier(0);
#pragma unroll
            for (int mm = 0; mm < 2; ++mm) { const int m = m0 + mm; const int rt = r0 + ai * 128 + m * 16; bf16_t* mp = MIXED + (size_t)(u.pm * 256 + rt) * 1024 + u.pn * 256 + c0;
#pragma unroll
                for (int bj = 0; bj < 2; ++bj) { const pg8::f32x4 a0 = acc[ai][bj][m][0], a1 = acc[ai][bj][m][1]; const u32x4 g = gv[mm][bj]; u32x4 w;
                    float v[8] = {bflo(g.x) * a0[0], bfhi(g.x) * a0[1], bflo(g.y) * a0[2], bfhi(g.y) * a0[3], bflo(g.z) * a1[0], bfhi(g.z) * a1[1], bflo(g.w) * a1[2], bfhi(g.w) * a1[3]};
                    if (ACCUM) { const u32x4 o = ov[mm][bj];
                        v[0] += bflo(o.x); v[1] += bfhi(o.x); v[2] += bflo(o.y); v[3] += bfhi(o.y); v[4] += bflo(o.z); v[5] += bfhi(o.z); v[6] += bflo(o.w); v[7] += bfhi(o.w); }
                    w.x = pg8::cvt_pk_bf16(v[0], v[1]); w.y = pg8::cvt_pk_bf16(v[2], v[3]); w.z = pg8::cvt_pk_bf16(v[4], v[5]); w.w = pg8::cvt_pk_bf16(v[6], v[7]);
                    *(u32x4*)(mp + bj * 128) = w; } }
        }
    }
    __device__ __forceinline__ void operator()(const pg8::f32x4 (&acc)[2][2][4][2], const pg8::Unit& u, int wr, int wc, int fr_, int fq_) const {
        int fr = fr_, fq = fq_; asm volatile("" : "+v"(fr), "+v"(fq));
        const int kind = u.tag & 1, cc = u.tag >> 1;
        if (kind == 0) {
            bf16_t* scr = (bf16_t*)(ws + WS_GSCR) + (size_t)blockIdx.x * 65536;
            const int r0 = wr * 64 + fr, c0 = wc * 32 + 8 * fq;
#pragma unroll
            for (int ai = 0; ai < 2; ++ai)
#pragma unroll
                for (int m = 0; m < 4; ++m) { const int rt = r0 + ai * 128 + m * 16; bf16_t* sp = scr + rt * 256 + c0;
#pragma unroll
                    for (int bj = 0; bj < 2; ++bj) { const pg8::f32x4 a0 = acc[ai][bj][m][0], a1 = acc[ai][bj][m][1]; u32x4 w;
                        w.x = pg8::cvt_pk_bf16(fsig(a0[0]), fsig(a0[1])); w.y = pg8::cvt_pk_bf16(fsig(a0[2]), fsig(a0[3]));
                        w.z = pg8::cvt_pk_bf16(fsig(a1[0]), fsig(a1[1])); w.w = pg8::cvt_pk_bf16(fsig(a1[2]), fsig(a1[3]));
                        *(u32x4*)(sp + bj * 128) = w; } }
        } else if (cc == 0) run1<false>(acc, u, wr, wc, fr, fq);
        else run1<true>(acc, u, wr, wc, fr, fq);
    }
};
struct EpiOut {
    static constexpr bool PERM = false, AFTER_DRAIN = false;
    const float* x; float* out;
    __device__ __forceinline__ void operator()(const pg8::f32x4 (&acc)[2][2][4][2], const pg8::Unit& u, int wr, int wc, int fr_, int fq_) const {
        int fr = fr_, fq = fq_; asm volatile("" : "+v"(fr), "+v"(fq));
        const int row0 = u.pm * 256 + wr * 64 + fr, col0 = u.pn * 256 + wc * 32 + 4 * fq;
#pragma unroll
        for (int am = 0; am < 4; ++am) {
            const int ai = am >> 1, m0 = (am & 1) * 2;
            pg8::f32x4 xv[2][2][2];
#pragma unroll
            for (int mm = 0; mm < 2; ++mm) { const size_t off = (size_t)(row0 + ai * 128 + (m0 + mm) * 16) * 1024 + col0;
#pragma unroll
                for (int bj = 0; bj < 2; ++bj)
#pragma unroll
                    for (int n = 0; n < 2; ++n) xv[mm][bj][n] = *(const pg8::f32x4*)(x + off + bj * 128 + n * 16); }
            __builtin_amdgcn_sched_barrier(0);
#pragma unroll
            for (int mm = 0; mm < 2; ++mm) { const size_t off = (size_t)(row0 + ai * 128 + (m0 + mm) * 16) * 1024 + col0;
#pragma unroll
                for (int bj = 0; bj < 2; ++bj)
#pragma unroll
                    for (int n = 0; n < 2; ++n) *(pg8::f32x4*)(out + off + bj * 128 + n * 16) = xv[mm][bj][n] + acc[ai][bj][m0 + mm][n]; }
        }
    }
};

struct SchedCmp {
    const char* UK; const char* UV; const char* B; int u;
    __device__ __forceinline__ bool next(int i, pg8::Unit& un) const { if (i > 0) return false; un.pm = u & 15; un.pn = 0; un.tag = u >> 4; return true; }
    __device__ __forceinline__ const char* pa(const pg8::Unit& un) const { return (un.tag ? UV : UK) + (size_t)un.pm * (256 * 2048 * 2); }
    __device__ __forceinline__ const char* pb(const pg8::Unit& un) const { return B + (size_t)un.tag * (256 * 2048 * 2); }
    __device__ __forceinline__ void a_ready(const pg8::Unit&) const {}
    __device__ __forceinline__ void done(const pg8::Unit&) const {}
};
__device__ __forceinline__ float gelu_tanh_(float x) { const float u = 0.7978845608028654f * (x + 0.044715f * x * x * x); return x * fsig(2.f * u); }
struct EpiCmp {
    static constexpr bool PERM = true, AFTER_DRAIN = false;
    bf16_t* H1;
    __device__ __forceinline__ void operator()(const pg8::f32x4 (&acc)[2][2][4][2], const pg8::Unit& u, int wr, int wc, int fr, int fq) const {
        bf16_t* base = H1 + (size_t)u.tag * 4096 * 256;
        const int row0 = u.pm * 256 + wr * 64 + fr, col0 = wc * 32 + 8 * fq;
#pragma unroll
        for (int ai = 0; ai < 2; ++ai)
#pragma unroll
            for (int m = 0; m < 4; ++m) { bf16_t* rowp = base + (size_t)(row0 + ai * 128 + m * 16) * 256 + col0;
#pragma unroll
                for (int bj = 0; bj < 2; ++bj) { const pg8::f32x4 v0 = acc[ai][bj][m][0], v1 = acc[ai][bj][m][1]; u32x4 w;
                    w.x = pg8::cvt_pk_bf16(gelu_tanh_(v0[0]), gelu_tanh_(v0[1])); w.y = pg8::cvt_pk_bf16(gelu_tanh_(v0[2]), gelu_tanh_(v0[3]));
                    w.z = pg8::cvt_pk_bf16(gelu_tanh_(v1[0]), gelu_tanh_(v1[1])); w.w = pg8::cvt_pk_bf16(gelu_tanh_(v1[2]), gelu_tanh_(v1[3]));
                    *(u32x4*)(rowp + bj * 128) = w; } }
    }
};
__device__ __forceinline__ void compress_stage2(const Params& p, int u) {
    typedef short bf16x8 __attribute__((ext_vector_type(8)));
    typedef float f32x16 __attribute__((ext_vector_type(16)));
    const int tid = threadIdx.x, lane = tid & 63, wid = tid >> 6, r32 = lane & 31, hi = lane >> 5, which = u >> 4, pm = u & 15;
    const bf16_t* hrow = (const bf16_t*)(p.ws + WS_H1) + ((size_t)which * 4096 + pm * 256 + 32 * wid + r32) * 256 + 8 * hi;
    const bf16_t* wrow = (const bf16_t*)(p.ws + WS_W2T) + ((size_t)which * 64 + r32) * 256 + 8 * hi;
    f32x16 a0, a1;
#pragma unroll
    for (int r = 0; r < 16; ++r) { a0[r] = 0.f; a1[r] = 0.f; }
#pragma unroll
    for (int ks = 0; ks < 16; ++ks) {
        const bf16x8 hf = *(const bf16x8*)(hrow + 16 * ks), w0 = *(const bf16x8*)(wrow + 16 * ks), w1 = *(const bf16x8*)(wrow + 32 * 256 + 16 * ks);
        a0 = __builtin_amdgcn_mfma_f32_32x32x16_bf16(hf, w0, a0, 0, 0, 0);
        a1 = __builtin_amdgcn_mfma_f32_32x32x16_bf16(hf, w1, a1, 0, 0, 0);
    }
    bf16_t* outb = (bf16_t*)(p.ws + (which ? WS_VC : WS_KC));
#pragma unroll
    for (int r = 0; r < 16; ++r) {
        const int rr = pm * 256 + 32 * wid + (r & 3) + 8 * (r >> 2) + 4 * hi;
        if (rr < NB * NCMP * 4) {
            const int b = rr / (NCMP * 4), rem = rr % (NCMP * 4), n = rem >> 2, h = rem & 3;
            bf16_t* op = outb + ((size_t)(b * 4 + h) * 512 + n) * 64 + r32;
            op[0] = f2bf(a0[r]); op[32] = f2bf(a1[r]);
            if (n == NCMP - 1) { op[64] = 0; op[96] = 0; }
        }
    }
}

__device__ __forceinline__ const float* bt_src_col(const Params& p, int n, int& ld) {
    ld = DIN;
    if (n < 512) return p.w_in + C_GQ + n;
    if (n < 1024) return p.w_in + C_GK + (n - 512);
    if (n < 2048) return p.w_in + C_GV + (n - 1024);
    if (n < 3072) return p.w_in + C_NQ + (n - 2048);
    if (n < 4608) return p.w_in + C_NKV + (n - 3072);
    if (n < 5632) return p.w_in + C_MQ + (n - 4608);
    if (n < 5648) return p.w_in + C_LR + (n - 5632);
    if (n < 5696) return p.w_in + C_NG + (n - 5648);
    if (n < 5888) return nullptr;
    if (n < 7936) { ld = 2048; return p.w_mem_kv + (n - 5888); }
    if (n < 8960) return p.w_in + C_GG + (n - 7936);
    if (n < 9984) return p.w_in + C_NGATE + (n - 8960);
    if (n < 11008) return p.w_in + C_MGATE + (n - 9984);
    if (n < 14080) return p.w_in + C_MERGE + (n - 11008);
    ld = 1024;
    if (n < 17152) { const int e = n - 14080; return p.w_branch + (size_t)(e >> 10) * 1024 * 1024 + (e & 1023); }
    return p.w_out + (n - 17152);
}
__device__ __forceinline__ void convert_item(const float* src0, int ld, bool gather, bool perm, const float* kgain, const Params& p, int nrow0, int k0, bf16_t* dst, int K, float* tile, int tid) {
    __syncthreads();
    if (!gather) {
        const int wid = tid >> 6, lane = tid & 63;
#pragma unroll
        for (int i = 0; i < 8; ++i) { const int kk = 8 * wid + i; const float4 v = *(const float4*)(src0 + (size_t)(k0 + kk) * ld + 4 * lane);
            const float gk = kgain ? kgain[(k0 + kk) & 255] : 1.f;
            float* tp = tile + kk * 257 + 4 * lane; tp[0] = v.x * gk; tp[1] = v.y * gk; tp[2] = v.z * gk; tp[3] = v.w * gk; }
    } else {
        for (int e = tid; e < 64 * 256; e += NTHREADS) { const int kk = e >> 8, n = e & 255; int l2; const float* cp = bt_src_col(p, nrow0 + n, l2); tile[kk * 257 + n] = cp ? cp[(size_t)(k0 + kk) * l2] : 0.f; }
    }
    __syncthreads();
#pragma unroll
    for (int u = 0; u < 4; ++u) { const int pid = tid + 512 * u, n = pid >> 3, kc = pid & 7;
        const int nl = perm ? (64 * ((n >> 5) & 3) + 32 * (n >> 7) + (n & 31)) : n;
        const float* s = tile + (8 * kc) * 257 + nl;
        u32x4 o; o.x = pg8::cvt_pk_bf16(s[0], s[257]); o.y = pg8::cvt_pk_bf16(s[2 * 257], s[3 * 257]); o.z = pg8::cvt_pk_bf16(s[4 * 257], s[5 * 257]); o.w = pg8::cvt_pk_bf16(s[6 * 257], s[7 * 257]);
        *(u32x4*)(dst + (size_t)n * K + k0 + 8 * kc) = o; }
}
__device__ __forceinline__ void phase_convert(const Params& p, float* sm, int bid, int nb) {
    const int tid = threadIdx.x;
    bf16_t* BT = (bf16_t*)(p.ws + WS_BT); bf16_t* BTC = (bf16_t*)(p.ws + WS_BTC);
    constexpr int NB256 = R_END / 256, N1 = 16 * NB256, N2 = 2 * 32;
    for (int it = bid; it < N1 + N2; it += nb) {
        if (it < N1) {
            const int kb = it / NB256, nbk = it % NB256, nrow0 = 256 * nbk; int ld; const float* cp = bt_src_col(p, nrow0, ld);
            const bool perm = (nrow0 >= 2048 && nrow0 < 3840) || nrow0 == 4096;
            convert_item(cp, ld, nrow0 == R_SMALL, perm, (nrow0 >= R_B && nrow0 < R_B + 1024) ? p.gla_out_norm : nullptr, p, nrow0, 64 * kb, BT + (size_t)nrow0 * 1024, 1024, sm, tid);
        } else {
            const int r = it - N1, which = r >> 5, kb = r & 31;
            convert_item(which ? p.wv1 : p.wk1, 256, false, false, nullptr, p, 0, 64 * kb, BTC + (size_t)which * 256 * 2048, 2048, sm, tid);
        }
    }
    bf16_t* W2T = (bf16_t*)(p.ws + WS_W2T);
    for (int idx = bid * NTHREADS + tid; idx < 2 * 64 * 256; idx += nb * NTHREADS) {
        const int f = idx & 255, d = (idx >> 8) & 63, which = idx >> 14;
        W2T[idx] = f2bf((which ? p.wv2 : p.wk2)[f * 64 + d]);
    }
}

__device__ __forceinline__ int queue_pop(unsigned* ctr, LAS unsigned char* lds) {
    LAS int* slot = (LAS int*)(lds + LDS_BYTES - 64);
    __syncthreads();
    if (threadIdx.x == 0) *slot = (int)atomicAdd(ctr, 1u);
    __syncthreads();
    return *slot;
}
__device__ __forceinline__ void phase_prep(const Params& p, int bid, int nb) {
    const int tid = threadIdx.x, lane = tid & 63, wave = tid >> 6;
    const int gw = bid * NWAVES + wave, NGW = nb * NWAVES;
    bf16_t* XN = (bf16_t*)p.out;
    for (int r = gw; r < M; r += NGW) {
        const float4* xr = (const float4*)(p.x + (size_t)r * DM);
        float4 v[4]; float ss = 0.f;
#pragma unroll
        for (int j = 0; j < 4; ++j) { v[j] = xr[lane + 64 * j]; ss += v[j].x * v[j].x + v[j].y * v[j].y + v[j].z * v[j].z + v[j].w * v[j].w; }
        ss = wave_sum(ss);
        const float rs = rsqrtf(ss * (1.f / DM) + EPS);
#pragma unroll
        for (int j = 0; j < 4; ++j) {
            const float4 g = ((const float4*)p.norm_gain)[lane + 64 * j];
            u32x2 w; w.x = pg8::cvt_pk_bf16(v[j].x * rs * g.x, v[j].y * rs * g.y); w.y = pg8::cvt_pk_bf16(v[j].z * rs * g.z, v[j].w * rs * g.w);
            *(u32x2*)(XN + (size_t)r * DM + (lane + 64 * j) * 4) = w;
        }
    }
    for (int r = gw; r < NB * NMEM; r += NGW) {
        const float4* xr = (const float4*)(p.mem + (size_t)r * DM);
        float4 v[4]; float ss = 0.f;
#pragma unroll
        for (int j = 0; j < 4; ++j) { v[j] = xr[lane + 64 * j]; ss += v[j].x * v[j].x + v[j].y * v[j].y + v[j].z * v[j].z + v[j].w * v[j].w; }
        ss = wave_sum(ss);
        const float rs = rsqrtf(ss * (1.f / DM) + EPS);
#pragma unroll
        for (int j = 0; j < 4; ++j) {
            const float4 g = ((const float4*)p.mem_norm_gain)[lane + 64 * j];
            u32x2 w; w.x = pg8::cvt_pk_bf16(v[j].x * rs * g.x, v[j].y * rs * g.y); w.y = pg8::cvt_pk_bf16(v[j].z * rs * g.z, v[j].w * rs * g.w);
            *(u32x2*)(XN + (size_t)(M + r) * DM + (lane + 64 * j) * 4) = w;
        }
    }
    float* COS = (float*)(p.ws + WS_COS); float* SIN = (float*)(p.ws + WS_SIN);
    for (int idx = bid * NTHREADS + tid; idx < M * 32; idx += nb * NTHREADS) {
        const int t = idx >> 5, i = idx & 31;
        const float inv = powf(10000.0f, -(float)i / 32.0f);
        const float ang = (float)p.pos[t] * inv;
        const double ad = (double)ang, kk = rint(ad * 0.15915494309189535);
        const float red = (float)(ad - kk * 6.283185307179586);
        COS[idx] = cosf(red); SIN[idx] = sinf(red);
    }
}

constexpr size_t WS_DEC = WS_MEMN;
__device__ __forceinline__ void phase_gla_prepass(const Params& p, float* sm, unsigned* ctr) {
    const int tid = threadIdx.x, k = tid & 127, qtr = tid >> 7;
    bf16_t* GQK = (bf16_t*)(p.ws + WS_GQK); const float* SM = (const float*)(p.ws + WS_SM); float* DEC = (float*)(p.ws + WS_DEC);
    float* gl = sm;
    float* tot = sm + 64 * 128;
    for (;;) {
        const int it = queue_pop(ctr, (LAS unsigned char*)sm);
        if (it >= 1024) break;
        const int h = it & 3, bc = it >> 2, b = bc >> 7, c = bc & 127;
        const size_t tc = (size_t)b * SEQ + c * 64;
        float w[16];
#pragma unroll
        for (int r = 0; r < 16; ++r) w[r] = p.w_alpha[r * 512 + h * 128 + k];
        const float bias = p.b_alpha[h * 128 + k];
        float gcum[16]; float run = 0.f;
#pragma unroll
        for (int i = 0; i < 16; ++i) {
            const float4* lr = (const float4*)(SM + (tc + 16 * qtr + i) * 64);
            const float4 l0 = lr[0], l1 = lr[1], l2 = lr[2], l3 = lr[3];
            float z = bias + l0.x * w[0] + l0.y * w[1] + l0.z * w[2] + l0.w * w[3] + l1.x * w[4] + l1.y * w[5] + l1.z * w[6] + l1.w * w[7]
                    + l2.x * w[8] + l2.y * w[9] + l2.z * w[10] + l2.w * w[11] + l3.x * w[12] + l3.y * w[13] + l3.z * w[14] + l3.w * w[15];
            const float ez = __builtin_amdgcn_exp2f(-1.4426950408889634f * fabsf(z));
            const float ls = fminf(z, 0.f) - 0.6931471805599453f * __builtin_amdgcn_logf(1.f + ez);
            run += ls * (1.f / 16.f); gcum[i] = run;
        }
        __syncthreads();
        tot[qtr * 128 + k] = run;
        __syncthreads();
        const float s0 = tot[k], s1 = tot[128 + k], s2 = tot[256 + k], s3 = tot[384 + k];
        const float off = (qtr > 0 ? s0 : 0.f) + (qtr > 1 ? s1 : 0.f) + (qtr > 2 ? s2 : 0.f);
#pragma unroll
        for (int i = 0; i < 16; ++i) gl[(16 * qtr + i) * 128 + k] = gcum[i] + off;
        if (qtr == 0) { const float gref = s0 + s1, glast = gref + s2 + s3; float* d = DEC + (size_t)it * 384; d[k] = expf(gref); d[128 + k] = expf(glast); d[256 + k] = expf(glast - gref); }
        __syncthreads();
        {
            const int tok = tid >> 3, k0 = (tid & 7) * 16;
            bf16_t* qp = GQK + (tc + tok) * 1024 + h * 128 + k0;
#pragma unroll
            for (int hf = 0; hf < 2; ++hf) {
                const u32x4 wq = *(const u32x4*)(qp + 8 * hf), wk = *(const u32x4*)(qp + 512 + 8 * hf);
                const float qv[8] = {bflo(wq.x), bfhi(wq.x), bflo(wq.y), bfhi(wq.y), bflo(wq.z), bfhi(wq.z), bflo(wq.w), bfhi(wq.w)};
                const float kv[8] = {bflo(wk.x), bfhi(wk.x), bflo(wk.y), bfhi(wk.y), bflo(wk.z), bfhi(wk.z), bflo(wk.w), bfhi(wk.w)};
                float eq[8], ek[8];
#pragma unroll
                for (int e = 0; e < 8; ++e) { const int kk = k0 + 8 * hf + e; const float d = gl[tok * 128 + kk] - gl[31 * 128 + kk];
                    const float ex = __builtin_amdgcn_exp2f(1.4426950408889634f * d); eq[e] = qv[e] * ex; ek[e] = kv[e] * __builtin_amdgcn_rcpf(ex); }
                u32x4 oq, ok;
                oq.x = pg8::cvt_pk_bf16(eq[0], eq[1]); oq.y = pg8::cvt_pk_bf16(eq[2], eq[3]); oq.z = pg8::cvt_pk_bf16(eq[4], eq[5]); oq.w = pg8::cvt_pk_bf16(eq[6], eq[7]);
                ok.x = pg8::cvt_pk_bf16(ek[0], ek[1]); ok.y = pg8::cvt_pk_bf16(ek[2], ek[3]); ok.z = pg8::cvt_pk_bf16(ek[4], ek[5]); ok.w = pg8::cvt_pk_bf16(ek[6], ek[7]);
                *(u32x4*)(qp + 8 * hf) = oq; *(u32x4*)(qp + 512 + 8 * hf) = ok;
            }
        }
    }
}
namespace gla2 {
typedef short bf16x8 __attribute__((ext_vector_type(8)));
typedef short s16x4 __attribute__((ext_vector_type(4)));
typedef short v4i16_t __attribute__((ext_vector_type(4)));
typedef float f32x16 __attribute__((ext_vector_type(16)));
typedef LAS const unsigned char* lptr;
constexpr int CH = 1088;
constexpr int G_Q = 0, G_K = 16 * CH, G_V = 32 * CH, G_A = 40 * CH, G_S = 48 * CH, G_D = 64 * CH, G_O = G_D + 2048, OPITCH = 144;
__device__ __forceinline__ int img(int row, int col) { return (col >> 3) * CH + row * 16 + (col & 7) * 2; }
__device__ __forceinline__ int crow(int r, int hi) { return (r & 3) + 8 * (r >> 2) + 4 * hi; }
__device__ __forceinline__ s16x4 vtr(lptr p) { return __builtin_bit_cast(s16x4, __builtin_amdgcn_ds_read_tr16_b64_v4i16((LAS v4i16_t*)p)); }
__device__ __forceinline__ bf16x8 afrag(lptr base, int tile, int ks, int r32, int hi) { return *(LAS const bf16x8*)(base + (2 * ks + hi) * CH + (32 * tile + r32) * 16); }
__device__ __forceinline__ bf16x8 trfrag(lptr base, int ctile, int s, int lane) {
    const int g = lane >> 4, hi = lane >> 5, q = (lane & 15) >> 2, pp = lane & 3;
    lptr a = base + img(16 * s + 8 * hi + q, 32 * ctile + 16 * (g & 1) + 4 * pp);
    const s16x4 lo = vtr(a), hh = vtr(a + 64);
    return (bf16x8){lo[0], lo[1], lo[2], lo[3], hh[0], hh[1], hh[2], hh[3]};
}
}
__device__ __forceinline__ void gla_main(const Params& p, LAS unsigned char* lds, int item) {
    using namespace gla2;
    int tid_ = threadIdx.x; asm volatile("" : "+v"(tid_));
    const int tid = tid_, lane = tid & 63, wid = __builtin_amdgcn_readfirstlane(tid >> 6), r32 = lane & 31, hi = lane >> 5;
    const int dvq = item & 3, h = (item >> 2) & 3, b = item >> 4;
    const bf16_t* GQK = (const bf16_t*)(p.ws + WS_GQK); bf16_t* GV = (bf16_t*)(p.ws + WS_GV); const float* DEC = (const float*)(p.ws + WS_DEC);
    const lptr L = (lptr)lds;
    const int qrow0 = tid >> 4, qch = tid & 15, vrow = tid >> 3, vch = tid & 7;
    const bf16_t* qsrc = GQK + ((size_t)b * SEQ + qrow0) * 1024 + h * 128 + qch * 8;
    const bf16_t* vsrc = GV + ((size_t)b * SEQ + vrow) * 1024 + h * 256 + dvq * 64 + vch * 8;
    const float* dsrc = DEC + (size_t)(b * 128 * 4 + h) * 384 + (tid < 96 ? tid * 4 : 0);
    u32x4 rq0, rq1, rk0, rk1, rv; f32x4 rd;
#define GLA_LOAD(c) do { const size_t o_ = (size_t)(c) * 64 * 1024; rq0 = *(const u32x4*)(qsrc + o_); rq1 = *(const u32x4*)(qsrc + o_ + 32 * 1024); rk0 = *(const u32x4*)(qsrc + o_ + 512); rk1 = *(const u32x4*)(qsrc + o_ + 32 * 1024 + 512); \
        rv = *(const u32x4*)(vsrc + o_); rd = *(const f32x4*)(dsrc + (size_t)(c) * 4 * 384); } while (0)
#define GLA_BAR() do { asm volatile("s_waitcnt lgkmcnt(0)" ::: "memory"); __builtin_amdgcn_s_barrier(); asm volatile("" ::: "memory"); } while (0)
    f32x16 S;
#pragma unroll
    for (int r = 0; r < 16; ++r) S[r] = 0.f;
    const int kb = wid >> 1, vb = wid & 1;
    GLA_LOAD(0);
    { u32x4 z = {0u, 0u, 0u, 0u}; *(u32x4*)(p.ws + 262144 + (size_t)item * 8192 + tid * 16) = z; }
    for (int c = 0; c < SEQ / 64; ++c) {
        *(LAS u32x4*)(lds + G_Q + qch * CH + qrow0 * 16) = rq0; *(LAS u32x4*)(lds + G_Q + qch * CH + (qrow0 + 32) * 16) = rq1;
        *(LAS u32x4*)(lds + G_K + qch * CH + qrow0 * 16) = rk0; *(LAS u32x4*)(lds + G_K + qch * CH + (qrow0 + 32) * 16) = rk1;
        *(LAS u32x4*)(lds + G_V + vch * CH + vrow * 16) = rv;
        if (tid < 96) *(LAS f32x4*)(lds + G_D + tid * 16) = rd;
        GLA_BAR();
        GLA_LOAD(c + 1 < SEQ / 64 ? c + 1 : c);
#pragma unroll
        for (int a = 0; a < 4; ++a) {
            const int dk0 = 32 * kb + 8 * a + 4 * hi;
            const f32x4 er = *(LAS const f32x4*)(lds + G_D + dk0 * 4);
            u32x2 w; w.x = pg8::cvt_pk_bf16(S[4 * a] * er[0], S[4 * a + 1] * er[1]); w.y = pg8::cvt_pk_bf16(S[4 * a + 2] * er[2], S[4 * a + 3] * er[3]);
            *(LAS u32x2*)(lds + G_S + img(32 * vb + r32, dk0)) = w;
        }
        if (wid < 3) {
            const int tj = (wid == 2) ? 1 : 0, ti = (wid == 0) ? 0 : 1;
            f32x16 at;
#pragma unroll
            for (int r = 0; r < 16; ++r) at[r] = 0.f;
#pragma unroll
            for (int ks = 0; ks < 8; ++ks) at = __builtin_amdgcn_mfma_f32_32x32x16_bf16(afrag(L + G_K, tj, ks, r32, hi), afrag(L + G_Q, ti, ks, r32, hi), at, 0, 0, 0);
            const int lim = (ti == tj) ? (r32 - 4 * hi) : 64;
#pragma unroll
            for (int a = 0; a < 4; ++a) {
                const float v0 = (crow(4 * a, 0) <= lim) ? at[4 * a] : 0.f, v1 = (crow(4 * a + 1, 0) <= lim) ? at[4 * a + 1] : 0.f;
                const float v2 = (crow(4 * a + 2, 0) <= lim) ? at[4 * a + 2] : 0.f, v3 = (crow(4 * a + 3, 0) <= lim) ? at[4 * a + 3] : 0.f;
                u32x2 w; w.x = pg8::cvt_pk_bf16(v0, v1); w.y = pg8::cvt_pk_bf16(v2, v3);
                *(LAS u32x2*)(lds + G_A + img(32 * ti + r32, 32 * tj + 8 * a + 4 * hi)) = w;
            }
        }
        GLA_BAR();
        if (wid < 4) {
            const int ti = wid >> 1, vj = wid & 1;
            f32x16 o;
#pragma unroll
            for (int r = 0; r < 16; ++r) o[r] = 0.f;
#pragma unroll
            for (int ks = 0; ks < 8; ++ks) o = __builtin_amdgcn_mfma_f32_32x32x16_bf16(afrag(L + G_S, vj, ks, r32, hi), afrag(L + G_Q, ti, ks, r32, hi), o, 0, 0, 0);
            for (int s = 0; s < 2 * ti + 2; ++s) o = __builtin_amdgcn_mfma_f32_32x32x16_bf16(trfrag(L + G_V, vj, s, lane), afrag(L + G_A, ti, s, r32, hi), o, 0, 0, 0);
#pragma unroll
            for (int a = 0; a < 4; ++a) { u32x2 w; w.x = pg8::cvt_pk_bf16(o[4 * a], o[4 * a + 1]); w.y = pg8::cvt_pk_bf16(o[4 * a + 2], o[4 * a + 3]);
                *(LAS u32x2*)(lds + G_O + (32 * ti + r32) * OPITCH + (32 * vj + 8 * a + 4 * hi) * 2) = w; }
        }
        {
            f32x16 T;
#pragma unroll
            for (int r = 0; r < 16; ++r) T[r] = 0.f;
#pragma unroll
            for (int s = 0; s < 4; ++s) T = __builtin_amdgcn_mfma_f32_32x32x16_bf16(trfrag(L + G_K, kb, s, lane), trfrag(L + G_V, vb, s, lane), T, 0, 0, 0);
#pragma unroll
            for (int a = 0; a < 4; ++a) {
                const int dk0 = 32 * kb + 8 * a + 4 * hi;
                const f32x4 d1 = *(LAS const f32x4*)(lds + G_D + 512 + dk0 * 4), d2 = *(LAS const f32x4*)(lds + G_D + 1024 + dk0 * 4);
                S[4 * a] = d1[0] * S[4 * a] + d2[0] * T[4 * a]; S[4 * a + 1] = d1[1] * S[4 * a + 1] + d2[1] * T[4 * a + 1];
                S[4 * a + 2] = d1[2] * S[4 * a + 2] + d2[2] * T[4 * a + 2]; S[4 * a + 3] = d1[3] * S[4 * a + 3] + d2[3] * T[4 * a + 3];
            }
        }
        GLA_BAR();
        { const u32x4 w = *(LAS const u32x4*)(lds + G_O + vrow * OPITCH + vch * 16); *(u32x4*)(const_cast<bf16_t*>(vsrc) + (size_t)c * 64 * 1024) = w; }
    }
#undef GLA_LOAD
#undef GLA_BAR
    __syncthreads();
    {
        float* RSSQ = (float*)(p.ws + WS_RSTD);
        const int sub = lane >> 3, c8 = lane & 7;
        for (int r0 = wid * 8; r0 < SEQ; r0 += NWAVES * 8) {
            const int tr = r0 + sub;
            const u32x4 w = *(const u32x4*)(GV + ((size_t)b * SEQ + tr) * 1024 + h * 256 + dvq * 64 + 8 * c8);
            float ss = bflo(w.x) * bflo(w.x) + bfhi(w.x) * bfhi(w.x) + bflo(w.y) * bflo(w.y) + bfhi(w.y) * bfhi(w.y) + bflo(w.z) * bflo(w.z) + bfhi(w.z) * bfhi(w.z) + bflo(w.w) * bflo(w.w) + bfhi(w.w) * bfhi(w.w);
            ss += __shfl_xor(ss, 1); ss += __shfl_xor(ss, 2); ss += __shfl_xor(ss, 4);
            if (c8 == 0) RSSQ[((size_t)b * SEQ + tr) * 16 + h * 4 + dvq] = ss;
        }
    }
}

__device__ __forceinline__ void phase_memattn_mfma(const Params& p, int bid, int nb) {
    typedef short bf16x8 __attribute__((ext_vector_type(8)));
    typedef float f32x16 __attribute__((ext_vector_type(16)));
    int tid_ = threadIdx.x; asm volatile("" : "+v"(tid_));
    const int tid = tid_, lane = tid & 63, wave = tid >> 6, r32 = lane & 31, hi = lane >> 5;
    const int gw = bid * NWAVES + wave, NGW = nb * NWAVES;
    bf16_t* MQ = (bf16_t*)(p.ws + WS_MQ); const bf16_t* MKB = (const bf16_t*)(p.ws + WS_MKB); const bf16_t* MVT = (const bf16_t*)(p.ws + WS_MVT);
    constexpr float C2M = 1.0f;
    for (int it = gw; it < (M / 32) * 4; it += NGW) {
        const int h = it & 3, tb = it >> 2, b = tb / (SEQ / 32);
        const int qoff = (tb * 32 + r32) * 1024 + h * 256;
        const bf16_t* kb = MKB + (size_t)(b * 4 + h) * 65536; const bf16_t* vt = MVT + (size_t)(b * 4 + h) * 65536;
        f32x16 s[8];
#pragma unroll
        for (int kt = 0; kt < 8; ++kt) {
            asm volatile("" ::: "memory");
#pragma unroll
            for (int r = 0; r < 16; ++r) s[kt][r] = 0.f;
#pragma unroll
            for (int ks = 0; ks < 16; ++ks) { const bf16x8 qf = *(const bf16x8*)(MQ + qoff + 16 * ks + 8 * hi);
                const bf16x8 kf = *(const bf16x8*)(kb + (32 * kt + r32) * 256 + 16 * ks + 8 * hi); s[kt] = __builtin_amdgcn_mfma_f32_32x32x16_bf16(kf, qf, s[kt], 0, 0, 0); }
        }
        asm volatile("" ::: "memory");
        float mx = -INFINITY;
#pragma unroll
        for (int kt = 0; kt < 8; ++kt)
#pragma unroll
            for (int r = 0; r < 16; ++r) mx = fmaxf(mx, s[kt][r]);
        mx = fmaxf(mx, __shfl_xor(mx, 32)) * C2M;
        float l = 0.f;
#pragma unroll
        for (int kt = 0; kt < 8; ++kt)
#pragma unroll
            for (int r = 0; r < 16; ++r) { s[kt][r] = __builtin_amdgcn_exp2f(s[kt][r] * C2M - mx); l += s[kt][r]; }
        l += __shfl_xor(l, 32);
        const float linv = 1.f / l;
        u32x4 pw[16];
#pragma unroll
        for (int st = 0; st < 16; ++st) { const int kt = st >> 1, r0 = 8 * (st & 1);
            pw[st].x = pg8::cvt_pk_bf16(s[kt][r0] * linv, s[kt][r0 + 1] * linv); pw[st].y = pg8::cvt_pk_bf16(s[kt][r0 + 2] * linv, s[kt][r0 + 3] * linv);
            pw[st].z = pg8::cvt_pk_bf16(s[kt][r0 + 4] * linv, s[kt][r0 + 5] * linv); pw[st].w = pg8::cvt_pk_bf16(s[kt][r0 + 6] * linv, s[kt][r0 + 7] * linv); }
#pragma unroll 1
        for (int dt = 0; dt < 8; ++dt) {
            f32x16 o;
#pragma unroll
            for (int r = 0; r < 16; ++r) o[r] = 0.f;
            const bf16_t* vrow = vt + (32 * dt + r32) * 256 + 4 * hi;
#pragma unroll
            for (int st = 0; st < 16; ++st) {
                const u32x2 lo = *(const u32x2*)(vrow + 16 * st), hh = *(const u32x2*)(vrow + 16 * st + 8);
                const u32x4 vf = {lo.x, lo.y, hh.x, hh.y};
                o = __builtin_amdgcn_mfma_f32_32x32x16_bf16(__builtin_bit_cast(bf16x8, vf), __builtin_bit_cast(bf16x8, pw[st]), o, 0, 0, 0);
            }
#pragma unroll
            for (int a = 0; a < 4; ++a) { u32x2 w; w.x = pg8::cvt_pk_bf16(o[4 * a], o[4 * a + 1]); w.y = pg8::cvt_pk_bf16(o[4 * a + 2], o[4 * a + 3]);
                *(u32x2*)(MQ + qoff + 32 * dt + 8 * a + 4 * hi) = w; }
        }
    }
}
__device__ __forceinline__ void phase_memattn_lds(const Params& p, LAS unsigned char* lds, unsigned* ctr) {
    typedef short bf16x8 __attribute__((ext_vector_type(8)));
    typedef float f32x16 __attribute__((ext_vector_type(16)));
    int tid_ = threadIdx.x; asm volatile("" : "+v"(tid_));
    const int tid = tid_, lane = tid & 63, wid = __builtin_amdgcn_readfirstlane(tid >> 6), r32 = lane & 31, hi = lane >> 5;
    float gq = 0.f, gk = 0.f;
#pragma unroll
    for (int j = 0; j < 4; ++j) { gq = fmaxf(gq, fabsf(p.mem_q_norm[lane + 64 * j])); gk = fmaxf(gk, fabsf(p.mem_k_norm[lane + 64 * j])); }
    gq = wave_max(gq); gk = wave_max(gk);
    const float B = 23.0831207f * 1.02f * gq * gk;
    if (__builtin_amdgcn_readfirstlane((int)(B < 60.f)) == 0) {
        if (queue_pop(ctr, lds) < (int)gridDim.x) phase_memattn_mfma(p, blockIdx.x, gridDim.x); return; }
    bf16_t* MQ = (bf16_t*)(p.ws + WS_MQ); const bf16_t* MKB = (const bf16_t*)(p.ws + WS_MKB); const bf16_t* MVT = (const bf16_t*)(p.ws + WS_MVT);
    constexpr int KCH = 1040, VROW = 272, BUF = 36864, OSTP = 272;
#define MEM_LDK(tile) do { _Pragma("unroll") for (int u = 0; u < 4; ++u) { const int pid = tid + 512 * u; st[u] = *(const u32x4*)(kb + (64 * (tile) + (pid >> 5)) * 256 + (pid & 31) * 8); } } while (0)
#define MEM_STK(buf) do { _Pragma("unroll") for (int u = 0; u < 4; ++u) { const int pid = tid + 512 * u; *(LAS u32x4*)(lds + (buf) * BUF + (pid & 31) * KCH + (pid >> 5) * 16) = st[u]; } } while (0)
#define MEM_LDV(ph, kt) do { _Pragma("unroll") for (int u = 0; u < 4; ++u) { const int pid = tid + 512 * u; st[u] = *(const u32x4*)(vt + (128 * (ph) + (pid >> 4)) * 256 + 128 * (kt) + (pid & 15) * 8); } } while (0)
#define MEM_STV(buf) do { _Pragma("unroll") for (int u = 0; u < 4; ++u) { const int pid = tid + 512 * u; *(LAS u32x4*)(lds + (buf) * BUF + (pid >> 4) * VROW + (pid & 15) * 16) = st[u]; } } while (0)
    for (;;) {
        const int item = queue_pop(ctr, lds);
        if (item >= 256) break;
        int tidi = tid_; asm volatile("" : "+v"(tidi));
        const int tid = tidi, lane = tid & 63, r32 = lane & 31, hi = lane >> 5;
        const int bh = item >> 5, tb = item & 31, b = bh >> 2, h = bh & 3;
        const int qoff = (b * SEQ + tb * 256 + 32 * wid + r32) * 1024 + h * 256;
        const bf16_t* kb = MKB + (size_t)bh * 65536; const bf16_t* vt = MVT + (size_t)bh * 65536;
        u32x4 st[4];
        MEM_LDK(0);
        bf16x8 qf[16];
#pragma unroll
        for (int ks = 0; ks < 16; ++ks) qf[ks] = *(const bf16x8*)(MQ + qoff + 16 * ks + 8 * hi);
        MEM_STK(0); MEM_LDK(1);
        __syncthreads();
        u32x4 pw[16]; float l = 0.f;
#pragma unroll
        for (int t = 0; t < 4; ++t) {
            const LAS unsigned char* kbuf = lds + (t & 1) * BUF;
#pragma unroll
            for (int kh = 0; kh < 2; ++kh) {
                f32x16 pp;
#pragma unroll
                for (int r = 0; r < 16; ++r) pp[r] = -B;
#pragma unroll
                for (int kq = 0; kq < 2; ++kq) {
                    bf16x8 kf[8];
#pragma unroll
                    for (int i = 0; i < 8; ++i) kf[i] = *(LAS const bf16x8*)(kbuf + (2 * (8 * kq + i) + hi) * KCH + r32 * 16 + 512 * kh);
#pragma unroll
                    for (int i = 0; i < 8; ++i) pp = __builtin_amdgcn_mfma_f32_32x32x16_bf16(kf[i], qf[8 * kq + i], pp, 0, 0, 0);
                    __builtin_amdgcn_sched_group_barrier(0x100, 8, 5); __builtin_amdgcn_sched_group_barrier(0x008, 8, 5);
                }
#pragma unroll
                for (int r = 0; r < 16; ++r) { pp[r] = __builtin_amdgcn_exp2f(pp[r]); l += pp[r]; }
                u32x4 wa, wb;
                wa.x = pg8::cvt_pk_bf16(pp[0], pp[1]); wa.y = pg8::cvt_pk_bf16(pp[2], pp[3]); wa.z = pg8::cvt_pk_bf16(pp[4], pp[5]); wa.w = pg8::cvt_pk_bf16(pp[6], pp[7]);
                wb.x = pg8::cvt_pk_bf16(pp[8], pp[9]); wb.y = pg8::cvt_pk_bf16(pp[10], pp[11]); wb.z = pg8::cvt_pk_bf16(pp[12], pp[13]); wb.w = pg8::cvt_pk_bf16(pp[14], pp[15]);
                pw[4 * t + 2 * kh] = wa; pw[4 * t + 2 * kh + 1] = wb;
            }
            if (t < 3) { MEM_STK((t + 1) & 1); if (t < 2) MEM_LDK(t + 2); else MEM_LDV(0, 0); }
            else { MEM_STV(0); MEM_LDV(0, 1); }
            __syncthreads();
        }
        const float lt = l + __shfl_xor(l, 32), linv = 1.f / lt;
#pragma unroll
        for (int ph = 0; ph < 2; ++ph) {
            f32x16 o[4];
#pragma unroll
            for (int dt = 0; dt < 4; ++dt)
#pragma unroll
                for (int r = 0; r < 16; ++r) o[dt][r] = 0.f;
#pragma unroll
            for (int kt = 0; kt < 2; ++kt) {
                const LAS unsigned char* vbuf = lds + kt * BUF;
#pragma unroll
                for (int dt = 0; dt < 4; ++dt) {
                    const LAS unsigned char* vr = vbuf + (32 * dt + r32) * VROW + 8 * hi;
                    u32x2 lo[8], hh[8];
#pragma unroll
                    for (int s = 0; s < 8; ++s) { lo[s] = *(LAS const u32x2*)(vr + 32 * s); hh[s] = *(LAS const u32x2*)(vr + 32 * s + 16); }
#pragma unroll
                    for (int s = 0; s < 8; ++s) {
                        const u32x4 vf = {lo[s][0], lo[s][1], hh[s][0], hh[s][1]};
                        o[dt] = __builtin_amdgcn_mfma_f32_32x32x16_bf16(__builtin_bit_cast(bf16x8, vf), __builtin_bit_cast(bf16x8, pw[8 * kt + s]), o[dt], 0, 0, 0);
                    }
                    __builtin_amdgcn_sched_group_barrier(0x100, 16, 6); __builtin_amdgcn_sched_group_barrier(0x008, 8, 6);
                }
                const int nx = 2 * ph + kt + 1;
                if (nx < 4) { MEM_STV(nx & 1); if (nx < 3) MEM_LDV((nx + 1) >> 1, (nx + 1) & 1); __syncthreads(); }
            }
            {
                LAS unsigned char* ost = lds + 2 * BUF + (32 * wid) * OSTP;
#pragma unroll
                for (int dt = 0; dt < 4; ++dt)
#pragma unroll
                    for (int a = 0; a < 4; ++a) { u32x2 w; w.x = pg8::cvt_pk_bf16(o[dt][4 * a] * linv, o[dt][4 * a + 1] * linv); w.y = pg8::cvt_pk_bf16(o[dt][4 * a + 2] * linv, o[dt][4 * a + 3] * linv);
                        *(LAS u32x2*)(ost + r32 * OSTP + (32 * dt + 8 * a + 4 * hi) * 2) = w; }
                asm volatile("s_waitcnt lgkmcnt(0)" ::: "memory");
                bf16_t* orow = MQ + (size_t)(b * SEQ + tb * 256 + 32 * wid) * 1024 + h * 256 + 128 * ph;
#pragma unroll
                for (int i = 0; i < 8; ++i) { const int pc = lane + 64 * i, row = pc >> 4, c16 = pc & 15;
                    const u32x4 w = *(LAS const u32x4*)(ost + row * OSTP + c16 * 16);
                    *(u32x4*)(orow + (size_t)row * 1024 + c16 * 8) = w; }
                asm volatile("s_waitcnt lgkmcnt(0)" ::: "memory");
            }
        }
    }
#undef MEM_LDK
#undef MEM_STK
#undef MEM_LDV
#undef MEM_STV
}
namespace nsa2 {
typedef short bf16x8 __attribute__((ext_vector_type(8)));
typedef short s16x4 __attribute__((ext_vector_type(4)));
typedef short v4i16_t __attribute__((ext_vector_type(4)));
typedef float f32x16 __attribute__((ext_vector_type(16)));
typedef LAS const unsigned char* lptr;
constexpr int IP = 136;
constexpr int L_K = 0, L_V = 16384, L_IA = 32768, L_IB = L_IA + 64 * IP * 4, L_CTR = L_IB + 64 * IP * 4, L_Q = L_CTR + 256;
constexpr float C2 = 0.125f * 1.4426950408889634f;
__device__ __forceinline__ int crow(int r, int hi) { return (r & 3) + 8 * (r >> 2) + 4 * hi; }
__device__ __forceinline__ s16x4 vtr(lptr p) { return __builtin_bit_cast(s16x4, __builtin_amdgcn_ds_read_tr16_b64_v4i16((LAS v4i16_t*)p)); }
__device__ __forceinline__ int tile_koff(int pitch, int wid, int lane) { return lane * pitch + wid * 8; }
__device__ __forceinline__ int tile_voff(int pitch, int wid, int lane) { return (16 * (wid & 3) + (lane >> 2)) * pitch + (wid >> 2) * 32 + (lane & 3) * 8; }
__device__ __forceinline__ void tile_load(u32x4& kr, u32x4& vr, const bf16_t* kb, const bf16_t* vb, int koff, int voff) {
    kr = *(const u32x4*)(kb + koff);
    vr = *(const u32x4*)(vb + voff);
}
__device__ __forceinline__ void tile_store(LAS unsigned char* lds, int slot, const u32x4& kr, const u32x4& vr, int wid, int lane) {
    *(LAS u32x4*)(lds + L_K + slot * 8192 + wid * 1024 + lane * 16) = kr;
    *(LAS u32x4*)(lds + L_V + slot * 8192 + wid * 1024 + lane * 16) = vr;
}
__device__ __forceinline__ void qkt(f32x16& p0, f32x16& p1, lptr Kslot, lptr qr, int r32, int hi, float init = 0.f) {
    lptr kb = Kslot + hi * 1024 + r32 * 16;
#pragma unroll
    for (int r = 0; r < 16; ++r) { p0[r] = init; p1[r] = init; }
    bf16x8 b0[4], b1[4], qf[4];
#pragma unroll
    for (int d0 = 0; d0 < 4; ++d0) { b0[d0] = *(LAS const bf16x8*)(kb + d0 * 2048); b1[d0] = *(LAS const bf16x8*)(kb + d0 * 2048 + 512); qf[d0] = *(LAS const bf16x8*)(qr + d0 * 8192); }
#pragma unroll
    for (int d0 = 0; d0 < 4; ++d0) {
        p0 = __builtin_amdgcn_mfma_f32_32x32x16_bf16(b0[d0], qf[d0], p0, 0, 0, 0);
        p1 = __builtin_amdgcn_mfma_f32_32x32x16_bf16(b1[d0], qf[d0], p1, 0, 0, 0);
    }
    __builtin_amdgcn_sched_group_barrier(0x100, 9, 0);
    __builtin_amdgcn_sched_group_barrier(0x008, 2, 0);
    __builtin_amdgcn_sched_group_barrier(0x100, 3, 0);
    __builtin_amdgcn_sched_group_barrier(0x008, 6, 0);
}
__device__ __forceinline__ unsigned pk(float lo, float hi) { return pg8::cvt_pk_bf16(lo, hi); }
__device__ __forceinline__ int group8_sum(int v) {
    v += __builtin_amdgcn_mov_dpp(v, 0xB1, 0xF, 0xF, true);
    v += __builtin_amdgcn_mov_dpp(v, 0x4E, 0xF, 0xF, true);
    v += __builtin_amdgcn_mov_dpp(v, 0x141, 0xF, 0xF, true);
    return v;
}
__device__ __forceinline__ float quad_sum(float v) {
    v += __builtin_bit_cast(float, __builtin_amdgcn_mov_dpp(__builtin_bit_cast(int, v), 0xB1, 0xF, 0xF, true));
    v += __builtin_bit_cast(float, __builtin_amdgcn_mov_dpp(__builtin_bit_cast(int, v), 0x4E, 0xF, 0xF, true));
    return v;
}
__device__ __forceinline__ void pvt(f32x16 (&o)[2], lptr Vslot, const f32x16& p0, const f32x16& p1, int lane, int hi) {
    lptr vp = Vslot + ((lane >> 4) & 1) * 32 + (lane & 3) * 8 + (4 * hi + ((lane & 15) >> 2)) * 64;
    u32x4 w0, w1, w2, w3;
    w0.x = pk(p0[0], p0[1]); w0.y = pk(p0[2], p0[3]); w0.z = pk(p0[4], p0[5]); w0.w = pk(p0[6], p0[7]);
    w1.x = pk(p0[8], p0[9]); w1.y = pk(p0[10], p0[11]); w1.z = pk(p0[12], p0[13]); w1.w = pk(p0[14], p0[15]);
    w2.x = pk(p1[0], p1[1]); w2.y = pk(p1[2], p1[3]); w2.z = pk(p1[4], p1[5]); w2.w = pk(p1[6], p1[7]);
    w3.x = pk(p1[8], p1[9]); w3.y = pk(p1[10], p1[11]); w3.z = pk(p1[12], p1[13]); w3.w = pk(p1[14], p1[15]);
    const bf16x8 pw0 = __builtin_bit_cast(bf16x8, w0), pw1 = __builtin_bit_cast(bf16x8, w1), pw2 = __builtin_bit_cast(bf16x8, w2), pw3 = __builtin_bit_cast(bf16x8, w3);
    s16x4 lo[2][4], hh[2][4];
#pragma unroll
    for (int ks = 0; ks < 4; ++ks)
#pragma unroll
        for (int d0 = 0; d0 < 2; ++d0) { lo[d0][ks] = vtr(vp + d0 * 4096 + ks * 1024); hh[d0][ks] = vtr(vp + d0 * 4096 + ks * 1024 + 512); }
#define NSA_VF(d, k) (bf16x8){lo[d][k][0], lo[d][k][1], lo[d][k][2], lo[d][k][3], hh[d][k][0], hh[d][k][1], hh[d][k][2], hh[d][k][3]}
    o[0] = __builtin_amdgcn_mfma_f32_32x32x16_bf16(NSA_VF(0, 0), pw0, o[0], 0, 0, 0); o[1] = __builtin_amdgcn_mfma_f32_32x32x16_bf16(NSA_VF(1, 0), pw0, o[1], 0, 0, 0);
    o[0] = __builtin_amdgcn_mfma_f32_32x32x16_bf16(NSA_VF(0, 1), pw1, o[0], 0, 0, 0); o[1] = __builtin_amdgcn_mfma_f32_32x32x16_bf16(NSA_VF(1, 1), pw1, o[1], 0, 0, 0);
    o[0] = __builtin_amdgcn_mfma_f32_32x32x16_bf16(NSA_VF(0, 2), pw2, o[0], 0, 0, 0); o[1] = __builtin_amdgcn_mfma_f32_32x32x16_bf16(NSA_VF(1, 2), pw2, o[1], 0, 0, 0);
    o[0] = __builtin_amdgcn_mfma_f32_32x32x16_bf16(NSA_VF(0, 3), pw3, o[0], 0, 0, 0); o[1] = __builtin_amdgcn_mfma_f32_32x32x16_bf16(NSA_VF(1, 3), pw3, o[1], 0, 0, 0);
#undef NSA_VF
    __builtin_amdgcn_sched_group_barrier(0x100, 8, 1);
    __builtin_amdgcn_sched_group_barrier(0x008, 4, 1);
    __builtin_amdgcn_sched_group_barrier(0x100, 8, 1);
    __builtin_amdgcn_sched_group_barrier(0x008, 4, 1);
}
__device__ __forceinline__ float tile_max(const f32x16& p0, const f32x16& p1) {
    float a = fmaxf(p0[0], p1[0]);
#pragma unroll
    for (int r = 1; r < 16; ++r) a = fmaxf(a, fmaxf(p0[r], p1[r]));
    return fmaxf(a, __shfl_xor(a, 32));
}
__device__ __forceinline__ void osm_step(f32x16& p0, f32x16& p1, float& m, float& l, f32x16 (&o)[2], lptr Vslot, int lane, int hi) {
    const float mx = tile_max(p0, p1);
    const float mn = fmaxf(m, mx), mu = (mn == -INFINITY) ? 0.f : mn;
    const float alpha = __builtin_amdgcn_exp2f(m - mu);
    float ls = 0.f;
#pragma unroll
    for (int r = 0; r < 16; ++r) { p0[r] = __builtin_amdgcn_exp2f(p0[r] - mu); p1[r] = __builtin_amdgcn_exp2f(p1[r] - mu); ls += p0[r] + p1[r]; }
    l = l * alpha + ls; m = mn;
#pragma unroll
    for (int r = 0; r < 16; ++r) { o[0][r] *= alpha; o[1][r] *= alpha; }
    pvt(o, Vslot, p0, p1, lane, hi);
}
template <int MODE>
__device__ __forceinline__ void fast_first(u32x4& pk0, u32x4& pv0, u32x4& pk1, const bf16_t* kb, const bf16_t* vb, int kofs, int vofs, int blk) {
    const int jlo = (MODE == 1) ? max(0, blk - 8) : 0, nt = (MODE == 1) ? (blk - jlo + 1) : (blk + 1);
    const int j0 = (MODE == 1) ? blk : 0, j1 = (nt > 1) ? ((MODE == 1) ? jlo : 1) : j0;
    const __amdgpu_buffer_rsrc_t rk = __builtin_amdgcn_make_buffer_rsrc((void*)kb, (short)0, SEQ * 1536 * 2, 0x00020000), rv = __builtin_amdgcn_make_buffer_rsrc((void*)vb, (short)0, SEQ * 1536 * 2, 0x00020000);
    pk0 = __builtin_bit_cast(u32x4, __builtin_amdgcn_raw_buffer_load_b128(rk, (unsigned)kofs * 2u, (unsigned)j0 * (64u * 1536u * 2u), 0));
    pv0 = __builtin_bit_cast(u32x4, __builtin_amdgcn_raw_buffer_load_b128(rv, (unsigned)vofs * 2u, (unsigned)j0 * (64u * 1536u * 2u), 0));
    pk1 = __builtin_bit_cast(u32x4, __builtin_amdgcn_raw_buffer_load_b128(rk, (unsigned)kofs * 2u, (unsigned)j1 * (64u * 1536u * 2u), 0));
}
template <int MODE>
__device__ __forceinline__ void fast_loop(LAS unsigned char* lds, const bf16_t* kb, const bf16_t* vb, int kofs, int vofs, int blk, int tl, int t, unsigned long long mylo, unsigned long long myhi,
                                          float Bnd, lptr qr, f32x16 (&oacc)[2], float& l, int wid, int lane, int r32, int hi, u32x4 pk0, u32x4 pv0, u32x4 pk1) {
    const int jlo = (MODE == 1) ? max(0, blk - 8) : 0, nt = (MODE == 1) ? (blk - jlo + 1) : (blk + 1);
    auto tile_of = [&](int i) -> int { return (MODE == 1) ? ((i == 0) ? blk : jlo + i - 1) : i; };
    auto sel_of = [&](int j) -> bool { return (MODE == 1) ? true : ((j < 64) ? (((mylo >> j) & 1ull) != 0ull) : (((myhi >> (j - 64)) & 1ull) != 0ull)); };
    u32x4 krA, vrA, krB, vrB;
    const unsigned kofb = (unsigned)kofs * 2u, vofb = (unsigned)vofs * 2u;
    const __amdgpu_buffer_rsrc_t rk = __builtin_amdgcn_make_buffer_rsrc((void*)kb, (short)0, SEQ * 1536 * 2, 0x00020000), rv = __builtin_amdgcn_make_buffer_rsrc((void*)vb, (short)0, SEQ * 1536 * 2, 0x00020000);
    {
        const int j1 = tile_of(min(1, nt - 1)), j2 = tile_of(min(2, nt - 1));
        *(LAS u32x4*)(lds + L_K + wid * 1024 + lane * 16) = pk0; *(LAS u32x4*)(lds + L_V + wid * 1024 + lane * 16) = pv0;
        *(LAS u32x4*)(lds + L_K + 8192 + wid * 1024 + lane * 16) = pk1;
        krB = __builtin_bit_cast(u32x4, __builtin_amdgcn_raw_buffer_load_b128(rk, kofb, (unsigned)j2 * (64u * 1536u * 2u), 0));
        vrB = __builtin_bit_cast(u32x4, __builtin_amdgcn_raw_buffer_load_b128(rv, vofb, (unsigned)j1 * (64u * 1536u * 2u), 0));
    }
    __syncthreads();
    f32x16 sa0, sa1, sb0, sb1;
    {
        const bool s0 = sel_of(tile_of(0));
        if (__any(s0)) qkt(sa0, sa1, (lptr)lds + L_K, qr, r32, hi, s0 ? -Bnd : -INFINITY);
    }
    __syncthreads();
    auto step = [&](int i, f32x16& c0, f32x16& c1, f32x16& n0, f32x16& n1, u32x4& krL, u32x4& vrL, const u32x4& krS, const u32x4& vrS) {
        const int j = tile_of(i);
        krL = __builtin_bit_cast(u32x4, __builtin_amdgcn_raw_buffer_load_b128(rk, kofb, (unsigned)tile_of(min(i + 3, nt - 1)) * (64u * 1536u * 2u), 0));
        vrL = __builtin_bit_cast(u32x4, __builtin_amdgcn_raw_buffer_load_b128(rv, vofb, (unsigned)tile_of(min(i + 2, nt - 1)) * (64u * 1536u * 2u), 0));
        if (i + 1 < nt) { const bool sn = sel_of(tile_of(i + 1)); if (__any(sn)) qkt(n0, n1, (lptr)lds + L_K + ((i + 1) & 1) * 8192, qr, r32, hi, sn ? -Bnd : -INFINITY); }
        if (__any(sel_of(j))) {
            bool masked; int klo, khi;
            if (MODE == 0) { masked = (j == blk); klo = -64; khi = tl - 4 * hi; }
            else { masked = (j == blk) || (j == blk - 8); klo = t - 511 - 64 * j - 4 * hi; khi = t - 64 * j - 4 * hi; }
            if (masked) {
#pragma unroll
                for (int r = 0; r < 16; ++r) { const int kk = crow(r, 0); c0[r] = (kk >= klo && kk <= khi) ? __builtin_amdgcn_exp2f(c0[r]) : 0.f; c1[r] = (kk + 32 >= klo && kk + 32 <= khi) ? __builtin_amdgcn_exp2f(c1[r]) : 0.f; }
            } else {
#pragma unroll
                for (int r = 0; r < 16; ++r) { c0[r] = __builtin_amdgcn_exp2f(c0[r]); c1[r] = __builtin_amdgcn_exp2f(c1[r]); }
            }
            float ls = 0.f;
#pragma unroll
            for (int r = 0; r < 16; ++r) ls += c0[r] + c1[r];
            l += ls;
            pvt(oacc, (lptr)lds + L_V + (i & 1) * 8192, c0, c1, lane, hi);
        }
        *(LAS u32x4*)(lds + L_K + (i & 1) * 8192 + wid * 1024 + lane * 16) = krS;
        *(LAS u32x4*)(lds + L_V + ((i + 1) & 1) * 8192 + wid * 1024 + lane * 16) = vrS;
        __syncthreads();
    };
    for (int i = 0; i < nt; i += 2) {
        step(i, sa0, sa1, sb0, sb1, krA, vrA, krB, vrB);
        if (i + 1 < nt) step(i + 1, sb0, sb1, sa0, sa1, krB, vrB, krA, vrA);
    }
}
}

__device__ __forceinline__ void phase_nsa_mfma(const Params& p, LAS unsigned char* lds, int bid, int nb) {
    using namespace nsa2;
    int tid_ = threadIdx.x; asm volatile("" : "+v"(tid_));
    const int tid = tid_, lane = tid & 63, wid = __builtin_amdgcn_readfirstlane(tid >> 6), r32 = lane & 31, hi = lane >> 5;
    bf16_t* NQ = (bf16_t*)(p.ws + WS_NQ); const bf16_t* NKV = (const bf16_t*)(p.ws + WS_NKV);
    const bf16_t* KC = (const bf16_t*)(p.ws + WS_KC); const bf16_t* VC = (const bf16_t*)(p.ws + WS_VC); const float* SM = (const float*)(p.ws + WS_SM);
    LAS float* IA = (LAS float*)(lds + L_IA); LAS float* IB = (LAS float*)(lds + L_IB);
    const float gq = wave_max(fabsf(p.nsa_q_norm[lane])), gks = wave_max(fabsf(p.nsa_k_norm[64 + lane])), gkw = wave_max(fabsf(p.nsa_k_norm[128 + lane]));
    const float Bs = 11.54156f * 1.02f * gq * gks, Bw = 11.54156f * 1.02f * gq * gkw;
    const bool fast = __builtin_amdgcn_readfirstlane((int)((Bs < 60.f) && (Bw < 60.f))) != 0;
    unsigned* ctr = (unsigned*)(p.ws + 16384);
    int e_next = 0;
    if (tid == 0) e_next = (int)atomicAdd(ctr, 1u);
    for (;;) {
        __syncthreads();
        if (threadIdx.x == 0) *(LAS int*)(lds + L_CTR) = e_next;
        __syncthreads();
        const int e = *(LAS const int*)(lds + L_CTR);
        if (e >= 1024) break;
        const int blk = 127 - (e >> 3), bh = e & 7, b = bh >> 2, h = bh & 3;
        int tid_i = tid_; asm volatile("" : "+v"(tid_i));
        const int tid = tid_i, lane = tid & 63, r32 = lane & 31, hi = lane >> 5;
        const int t0 = blk * 64, tl = 8 * wid + (r32 >> 2), g = r32 & 3, t = t0 + tl;
        const int tg = b * SEQ + t;
        const int qoff = tg * 1024 + (4 * h + g) * 64;
        const lptr qr = (lptr)lds + L_Q + tid * 16;
        const int goff = tg * 64 + 16 + (4 * h + g) * 3;
        f32x16 ot[2];
        u32x4 kr, vr;
        const int kofc = tile_koff(64, wid, lane), vofc = tile_voff(64, wid, lane), kofs = tile_koff(1536, wid, lane), vofs = tile_voff(1536, wid, lane);
        const bf16_t* kcb = KC + (size_t)(b * 4 + h) * 512 * 64; const bf16_t* vcb = VC + (size_t)(b * 4 + h) * 512 * 64;
        const int nvmax = min(NCMP, 4 * blk + 3), ntc = (nvmax + 63) >> 6;
        const int nvq = (t >= 31) ? min(NCMP, (t - 31) / 16 + 1) : 0;
        float m = -INFINITY, l = 0.f;
        const __amdgpu_buffer_rsrc_t rkc = __builtin_amdgcn_make_buffer_rsrc((void*)kcb, (short)0, 512 * 64 * 2, 0x00020000), rvc = __builtin_amdgcn_make_buffer_rsrc((void*)vcb, (short)0, 512 * 64 * 2, 0x00020000);
        {
            bf16x8 qv[4];
#pragma unroll
            for (int d0 = 0; d0 < 4; ++d0) qv[d0] = *(const bf16x8*)(NQ + qoff + 16 * d0 + 8 * hi);
            tile_load(kr, vr, kcb, vcb, kofc, vofc);
#pragma unroll
            for (int d0 = 0; d0 < 4; ++d0) *(LAS bf16x8*)(lds + L_Q + d0 * 8192 + tid * 16) = qv[d0];
            tile_store(lds, 0, kr, vr, wid, lane);
        }
        const float graw0 = SM[goff], graw1 = SM[goff + 1], graw2 = SM[goff + 2];
        __syncthreads();
        for (int i = 0; i < ntc; ++i) {
            { const int inx = (i + 1 < ntc) ? i + 1 : 0;
              kr = __builtin_bit_cast(u32x4, __builtin_amdgcn_raw_buffer_load_b128(rkc, (unsigned)kofc * 2u, (unsigned)inx * 8192u, 0));
              vr = __builtin_bit_cast(u32x4, __builtin_amdgcn_raw_buffer_load_b128(rvc, (unsigned)vofc * 2u, (unsigned)inx * 8192u, 0)); }
            f32x16 p0, p1; qkt(p0, p1, (lptr)lds + L_K + (i & 1) * 8192, qr, r32, hi);
            const int n0 = 64 * i;
            const int nl = nvq - n0 - 4 * hi;
#pragma unroll
            for (int r = 0; r < 16; ++r) { p0[r] = (crow(r, 0) < nl) ? p0[r] : -INFINITY; p1[r] = (crow(r, 0) + 32 < nl) ? p1[r] : -INFINITY; }
            const float mx = tile_max(p0, p1), mn = fmaxf(m, mx), mu = (mn == -INFINITY) ? 0.f : mn;
            float ls = 0.f;
#pragma unroll
            for (int r = 0; r < 16; ++r) ls += __builtin_amdgcn_exp2f(p0[r] - mu) + __builtin_amdgcn_exp2f(p1[r] - mu);
            l = l * __builtin_amdgcn_exp2f(m - mu) + ls; m = mn;
            tile_store(lds, (i + 1) & 1, kr, vr, wid, lane);
            __syncthreads();
        }
        {
            const float lt = l + __shfl_xor(l, 32), linv = lt > 0.f ? 1.f / lt : 0.f, mu = (m == -INFINITY) ? 0.f : m;
            const float gate_c = sigmoidf_(graw0);
            f32x16 oc[2];
#pragma unroll
            for (int r = 0; r < 16; ++r) { oc[0][r] = 0.f; oc[1][r] = 0.f; }
            for (int i = 0; i < ntc; ++i) {
                const int sl = (ntc + i) & 1;
                { const int inx = (i + 1 < ntc) ? i + 1 : i;
                  kr = __builtin_bit_cast(u32x4, __builtin_amdgcn_raw_buffer_load_b128(rkc, (unsigned)kofc * 2u, (unsigned)inx * 8192u, 0));
                  vr = __builtin_bit_cast(u32x4, __builtin_amdgcn_raw_buffer_load_b128(rvc, (unsigned)vofc * 2u, (unsigned)inx * 8192u, 0)); }
                f32x16 p0, p1; qkt(p0, p1, (lptr)lds + L_K + sl * 8192, qr, r32, hi);
                const int n0 = 64 * i, nl = nvq - n0 - 4 * hi;
#pragma unroll
                for (int r = 0; r < 16; ++r) {
                    p0[r] = (crow(r, 0) < nl) ? __builtin_amdgcn_exp2f(p0[r] - mu) * linv : 0.f; p1[r] = (crow(r, 0) + 32 < nl) ? __builtin_amdgcn_exp2f(p1[r] - mu) * linv : 0.f; }
#pragma unroll
                for (int a = 0; a < 4; ++a) {
                    float A0 = p0[4 * a] + p0[4 * a + 1] + p0[4 * a + 2] + 0.5f * p0[4 * a + 3], B0 = 0.5f * p0[4 * a + 3];
                    float A1 = p1[4 * a] + p1[4 * a + 1] + p1[4 * a + 2] + 0.5f * p1[4 * a + 3], B1 = 0.5f * p1[4 * a + 3];
                    A0 = quad_sum(A0); B0 = quad_sum(B0); A1 = quad_sum(A1); B1 = quad_sum(B1);
                    const int s = (n0 >> 2) + 2 * a + hi;
                    if (g == 0) { IA[tl * IP + s] = A0; IB[tl * IP + s] = B0; IA[tl * IP + s + 8] = A1; IB[tl * IP + s + 8] = B1; }
                }
                pvt(oc, (lptr)lds + L_V + sl * 8192, p0, p1, lane, hi);
                if (i + 1 < ntc) tile_store(lds, sl ^ 1, kr, vr, wid, lane);
                __syncthreads();
            }
#pragma unroll
            for (int r = 0; r < 16; ++r) { ot[0][r] = gate_c * oc[0][r]; ot[1][r] = gate_c * oc[1][r]; }
        }
        const bf16_t* kbs = NKV + (size_t)b * SEQ * 1536 + 2 * 256 + h * 64;
        u32x4 pk0, pv0, pk1;
        fast_first<0>(pk0, pv0, pk1, kbs, kbs + 256, kofs, vofs, blk);
        unsigned long long mylo = 0ull, myhi = 0ull;
        {
            unsigned long long flo = 1ull, fhi = 0ull; int nforced = 1;
            if (blk >= 2) { const int s = blk - 1; if (s < 64) flo |= 1ull << s; else fhi |= 1ull << (s - 64); ++nforced; }
            if (blk >= 1) { const int s = blk; if (s < 64) flo |= 1ull << s; else fhi |= 1ull << (s - 64); ++nforced; }
            const int need = 16 - nforced, ncand = blk - 2;
            mylo = flo; myhi = fhi;
            if (ncand > 0) {
                const int k8 = lane >> 3, s8 = lane & 7, tk = 8 * wid + k8;
                unsigned u[16]; unsigned vbits = 0u;
#pragma unroll
                for (int j = 0; j < 16; ++j) { const int c = s8 + 8 * j; const bool v = (c >= 1) && (c <= blk - 2);
                    const float a = IA[tk * IP + c], b2 = IB[tk * IP + (c >= 1 ? c - 1 : 0)];
                    u[j] = v ? __float_as_uint(a + b2) : 0u; vbits |= (v ? 1u : 0u) << j; }
                unsigned selbits;
                if (ncand <= need) selbits = vbits;
                else {
                    unsigned T = 0u; bool done = false;
                    for (int bit = 30; bit >= 0; --bit) {
                        const unsigned cc = T | (1u << bit);
                        int cnt = 0;
#pragma unroll
                        for (int j = 0; j < 16; ++j) cnt += (u[j] >= cc) ? 1 : 0;
                        cnt = group8_sum(cnt);
                        if (!done) { if (cnt >= need) T = cc; if (cnt == need) { done = true; T = cc - 1u; } }
                        if (__all(done)) break;
                    }
                    int gt = 0; selbits = 0u;
#pragma unroll
                    for (int j = 0; j < 16; ++j) { const bool g1 = u[j] > T; gt += g1 ? 1 : 0; selbits |= (g1 ? 1u : 0u) << j; }
                    const int rem = need - group8_sum(gt);
                    if (__any(rem > 0)) {
                        int run = 0;
#pragma unroll
                        for (int j = 0; j < 16; ++j) { const bool eq = ((vbits >> j) & 1u) && (u[j] == T);
                            const unsigned long long bq = __ballot(eq);
                            const unsigned grp = (unsigned)(bq >> (8 * k8)) & 0xffu;
                            if (eq && (run + __popc(grp & ((1u << s8) - 1u)) < rem)) selbits |= 1u << j;
                            run += __popc(grp); }
                    }
                }
#pragma unroll
                for (int j = 0; j < 16; ++j) { const unsigned long long bs = __ballot(((selbits >> j) & 1u) != 0u);
                    const unsigned long long byte = (bs >> (8 * (r32 >> 2))) & 0xffull;
                    if (j < 8) mylo |= byte << (8 * j); else myhi |= byte << (8 * (j - 8)); }
            }
        }
        __syncthreads();
        LAS float* OT = (LAS float*)(lds + L_IA);
#pragma unroll
        for (int r = 0; r < 16; ++r) { OT[r * 512 + tid] = ot[0][r]; OT[(16 + r) * 512 + tid] = ot[1][r]; }
        {
            const bf16_t* kb = NKV + (size_t)b * SEQ * 1536 + 2 * 256 + h * 64; const bf16_t* vb = kb + 256;
            f32x16 os[2];
#pragma unroll
            for (int r = 0; r < 16; ++r) { os[0][r] = 0.f; os[1][r] = 0.f; }
            m = -INFINITY; l = 0.f;
            if (fast) fast_loop<0>(lds, kb, vb, kofs, vofs, blk, tl, t, mylo, myhi, Bs, qr, os, l, wid, lane, r32, hi, pk0, pv0, pk1);
            else {
            tile_load(kr, vr, kb, vb, kofs, vofs); tile_store(lds, 0, kr, vr, wid, lane);
            __syncthreads();
            for (int j = 0; j <= blk; ++j) {
                if (j < blk) tile_load(kr, vr, kb + (size_t)(j + 1) * 64 * 1536, vb + (size_t)(j + 1) * 64 * 1536, kofs, vofs);
                const bool sel = (j < 64) ? ((mylo >> j) & 1ull) : ((myhi >> (j - 64)) & 1ull);
                if (__any(sel)) {
                    f32x16 p0, p1;
                    {
                        qkt(p0, p1, (lptr)lds + L_K + (j & 1) * 8192, qr, r32, hi);
                        const int lim = (sel ? ((j == blk) ? tl : 63) : -1) - 4 * hi;
#pragma unroll
                        for (int r = 0; r < 16; ++r) { p0[r] = (crow(r, 0) <= lim) ? p0[r] : -INFINITY; p1[r] = (crow(r, 0) + 32 <= lim) ? p1[r] : -INFINITY; }
                        osm_step(p0, p1, m, l, os, (lptr)lds + L_V + (j & 1) * 8192, lane, hi);
                    }
                }
                if (j < blk) tile_store(lds, (j + 1) & 1, kr, vr, wid, lane);
                __syncthreads();
            }
            }
            fast_first<1>(pk0, pv0, pk1, kbs + 512, kbs + 768, kofs, vofs, blk);
            const float lt = l + __shfl_xor(l, 32), sc = sigmoidf_(graw1) * (lt > 0.f ? 1.f / lt : 0.f);
#pragma unroll
            for (int r = 0; r < 16; ++r) { OT[r * 512 + tid] += sc * os[0][r]; OT[(16 + r) * 512 + tid] += sc * os[1][r]; }
        }
        {
            const bf16_t* kb = NKV + (size_t)b * SEQ * 1536 + 4 * 256 + h * 64; const bf16_t* vb = kb + 256;
            f32x16 ow[2];
#pragma unroll
            for (int r = 0; r < 16; ++r) { ow[0][r] = 0.f; ow[1][r] = 0.f; }
            m = -INFINITY; l = 0.f;
            const int jlo = max(0, blk - 8), nt = blk - jlo + 1;
            if (fast) fast_loop<1>(lds, kb, vb, kofs, vofs, blk, tl, t, mylo, myhi, Bw, qr, ow, l, wid, lane, r32, hi, pk0, pv0, pk1);
            else {
            tile_load(kr, vr, kb + (size_t)blk * 64 * 1536, vb + (size_t)blk * 64 * 1536, kofs, vofs); tile_store(lds, 0, kr, vr, wid, lane);
            __syncthreads();
            for (int i = 0; i < nt; ++i) {
                const int j = (i == 0) ? blk : jlo + i - 1;
                if (i + 1 < nt) { const int jn = jlo + i; tile_load(kr, vr, kb + (size_t)jn * 64 * 1536, vb + (size_t)jn * 64 * 1536, kofs, vofs); }
                f32x16 p0, p1;
                const int klo = t - 511 - 64 * j - 4 * hi, khi = t - 64 * j - 4 * hi;
                {
                    qkt(p0, p1, (lptr)lds + L_K + (i & 1) * 8192, qr, r32, hi);
#pragma unroll
                    for (int r = 0; r < 16; ++r) { const int kk = crow(r, 0); p0[r] = (kk >= klo && kk <= khi) ? p0[r] : -INFINITY; p1[r] = (kk + 32 >= klo && kk + 32 <= khi) ? p1[r] : -INFINITY; }
                    osm_step(p0, p1, m, l, ow, (lptr)lds + L_V + (i & 1) * 8192, lane, hi);
                }
                if (i + 1 < nt) tile_store(lds, (i + 1) & 1, kr, vr, wid, lane);
                __syncthreads();
            }
            }
            const float lt = l + __shfl_xor(l, 32), sc = sigmoidf_(graw2) * (lt > 0.f ? 1.f / lt : 0.f);
#pragma unroll
            for (int r = 0; r < 16; ++r) { ot[0][r] = OT[r * 512 + tid] + sc * ow[0][r]; ot[1][r] = OT[(16 + r) * 512 + tid] + sc * ow[1][r]; }
        }
        if (threadIdx.x == 0) e_next = (int)atomicAdd(ctr, 1u);
        {
            LAS unsigned char* ost = lds + L_K + wid * 4096;
            const int k8 = r32 >> 2;
#pragma unroll
            for (int d0 = 0; d0 < 2; ++d0)
#pragma unroll
                for (int a = 0; a < 4; ++a) { u32x2 w; w.x = pk(ot[d0][4 * a], ot[d0][4 * a + 1]); w.y = pk(ot[d0][4 * a + 2], ot[d0][4 * a + 3]);
                    *(LAS u32x2*)(ost + k8 * 512 + ((g * 128 + 64 * d0 + 16 * a + 8 * hi) ^ (k8 << 4))) = w; }
            asm volatile("s_waitcnt lgkmcnt(0)" ::: "memory");
            bf16_t* orow = NQ + (size_t)(b * SEQ + t0 + 8 * wid) * 1024 + 4 * h * 64;
#pragma unroll
            for (int i = 0; i < 4; ++i) { const int pi = lane + 64 * i, rk = pi >> 5, j = pi & 31;
                const u32x4 w = *(LAS const u32x4*)(ost + rk * 512 + ((16 * j) ^ (rk << 4)));
                *(u32x4*)(orow + (size_t)rk * 1024 + j * 8) = w; }
            asm volatile("s_waitcnt lgkmcnt(0)" ::: "memory");
        }
    }
}

__device__ __forceinline__ Params kparams() {
#if defined(__HIP_DEVICE_COMPILE__)
    auto k = __builtin_amdgcn_kernarg_segment_ptr();
    asm volatile("" : "+s"(k));
    return *(const Params __attribute__((address_space(4)))*)k;
#else
    return Params{};
#endif
}
__global__ void __launch_bounds__(NTHREADS, 2) mega(Params p_unused) {
    cg::grid_group grid = cg::this_grid();
    extern __shared__ __attribute__((aligned(16))) unsigned char lds[];
    float* sm = (float*)lds;
    LAS unsigned char* lds3 = (LAS unsigned char*)lds;
    const int bid = blockIdx.x, nb = gridDim.x;
    volatile LAS unsigned* xst = (volatile LAS unsigned*)(lds3 + LDS_BYTES - 16);
    if (threadIdx.x < 4) xst[threadIdx.x] = 0u;
    __syncthreads();
    if (bid == 0) { const Params p = kparams(); u32x4* z = (u32x4*)p.ws;
#pragma unroll
        for (int i = 0; i < 32768 / 16 / NTHREADS; ++i) z[threadIdx.x + i * NTHREADS] = (u32x4){0u, 0u, 0u, 0u}; }
#define GRID_BAR() do { const Params pb_ = kparams(); XcdBarrier xb_; xb_.bar = (unsigned*)pb_.ws; xb_.x = xb_xcc_id(); xb_.st = (volatile LAS unsigned*)(lds3 + LDS_BYTES - 16); xcd_barrier(xb_); } while (0)
    { const Params p = kparams();
      phase_prep(p, bid, nb);
      phase_convert(p, sm, bid, nb); }
    grid.sync();
    { const Params p = kparams(); (void)xcd_barrier_post((unsigned*)p.ws, xst); }
    {
        const Params p = kparams(); const char* BT = (const char*)(p.ws + WS_BT);
        pg8::Gemm g{1024}; SchedEarly S{(const char*)p.out, BT, nb, bid}; EpiEarly E{p.ws, lds3, (bf16_t*)((unsigned char*)p.out + OUT_UV), p.nsa_q_norm, p.nsa_k_norm, p.pe_k, p.pe_v, p.mem_q_norm, p.mem_k_norm};
        pg8::gemm_phase<EpiEarly, SchedEarly, true, true>(lds3, g, S, E);
    }
    GRID_BAR();
    if (bid < 32) {
        const Params p = kparams();
        pg8::Gemm g{2048}; SchedCmp S{(const char*)(p.ws + WS_UK), (const char*)p.out + OUT_UV, (const char*)(p.ws + WS_BTC), bid}; EpiCmp E{(bf16_t*)(p.ws + WS_H1)};
        pg8::gemm_phase<EpiCmp, SchedCmp, true, true>(lds3, g, S, E);
        __syncthreads();
        compress_stage2(p, bid);
    }
    {
        const Params p = kparams();
        unsigned* ctr2 = (unsigned*)(p.ws + 16384 + 1024);
        phase_memattn_lds(p, lds3, ctr2);
        phase_gla_prepass(p, sm, ctr2 + 64);
    }
    GRID_BAR();
    if (bid < 32) { const Params p = kparams(); gla_main(p, lds3, bid); }
    { const Params p = kparams(); phase_nsa_mfma(p, lds3, bid, nb); }
    GRID_BAR();
    {
        const Params p = kparams(); const char* BT = (const char*)(p.ws + WS_BT);
        pg8::Gemm g{1024}; SchedPlain S{(const char*)p.out, BT + (size_t)R_G * 2048, 12, 768, nb, bid}; EpiGates E{p.ws};
        pg8::gemm_phase<EpiGates, SchedPlain, true, true>(lds3, g, S, E);
    }
    GRID_BAR();
    {
        const Params p = kparams(); const char* BT = (const char*)(p.ws + WS_BT);
        pg8::Gemm g{1024};
        SchedMix S{(const char*)p.out, (const char*)(p.ws + WS_GV), (const char*)(p.ws + WS_NQ), (const char*)(p.ws + WS_MQ), BT + (size_t)R_M * 2048, BT + (size_t)R_B * 2048, nb, bid};
        EpiMix E{p.ws};
        pg8::gemm_phase<EpiMix, SchedMix, true, true>(lds3, g, S, E);
    }
    GRID_BAR();
    {
        const Params p = kparams(); const char* BT = (const char*)(p.ws + WS_BT);
        pg8::Gemm g{1024}; SchedPlain S{(const char*)(p.ws + WS_GQK), BT + (size_t)R_O * 2048, 4, 256, nb, bid}; EpiOut E{p.x, p.out};
        pg8::gemm_phase<EpiOut, SchedPlain, true, true>(lds3, g, S, E);
    }
}
#undef GRID_BAR

extern "C" void kernel_launch(void* const* d_in, const int* in_sizes, int n_in, void* d_out, int out_size, void* d_ws, size_t ws_size, hipStream_t stream) {
    static int grid_blocks = 0;
    if (grid_blocks == 0) {
        if (n_in != 22 || in_sizes[0] != M * DM || out_size != M * DM || ws_size < WS_END2) {
            fprintf(stderr, "kernel_launch: unexpected shapes n_in %d in0 %d out %d ws %zu\n", n_in, n_in > 0 ? in_sizes[0] : -1, out_size, ws_size); grid_blocks = -1; return; }
        int dev = 0, cus = 0, per_cu = 0;
        hipGetDevice(&dev);
        hipDeviceGetAttribute(&cus, hipDeviceAttributeMultiprocessorCount, dev);
        hipFuncSetAttribute((const void*)mega, hipFuncAttributeMaxDynamicSharedMemorySize, LDS_BYTES);
        hipOccupancyMaxActiveBlocksPerMultiprocessor(&per_cu, (const void*)mega, NTHREADS, LDS_BYTES);
        if (per_cu < 1) { fprintf(stderr, "kernel_launch: occupancy query says %d blocks per CU\n", per_cu); per_cu = 1; }
        grid_blocks = cus * per_cu;
        fprintf(stderr, "kernel_launch: %d CUs x %d = grid %d\n", cus, per_cu, grid_blocks);
    }
    if (grid_blocks < 0) return;
    Params p{};
    p.x = (const float*)d_in[0]; p.mem = (const float*)d_in[1]; p.pos = (const int*)d_in[2]; p.norm_gain = (const float*)d_in[3]; p.mem_norm_gain = (const float*)d_in[4];
    p.w_in = (const float*)d_in[5]; p.w_alpha = (const float*)d_in[6]; p.b_alpha = (const float*)d_in[7]; p.gla_out_norm = (const float*)d_in[8]; p.nsa_q_norm = (const float*)d_in[9];
    p.nsa_k_norm = (const float*)d_in[10]; p.pe_k = (const float*)d_in[11]; p.pe_v = (const float*)d_in[12]; p.wk1 = (const float*)d_in[13]; p.wk2 = (const float*)d_in[14];
    p.wv1 = (const float*)d_in[15]; p.wv2 = (const float*)d_in[16]; p.w_mem_kv = (const float*)d_in[17]; p.mem_q_norm = (const float*)d_in[18]; p.mem_k_norm = (const float*)d_in[19];
    p.w_branch = (const float*)d_in[20]; p.w_out = (const float*)d_in[21];
    p.out = (float*)d_out; p.ws = (unsigned char*)d_ws;
    void* args[] = {&p};
    hipError_t e = hipLaunchCooperativeKernel((const void*)mega, dim3(grid_blocks), dim3(NTHREADS), args, LDS_BYTES, stream);
    if (e != hipSuccess) fprintf(stderr, "cooperative launch failed: %s (grid %d)\n", hipGetErrorString(e), grid_blocks);
}
```
